# Optimizing an MI355X kernel written in HIP

```python
import jax, jax.numpy as jnp
from jax import lax
import numpy as np

D_MODEL = 1024
BATCH = 16
SEQ = 4096
DEPTH = 4

GRID_W = 64
CTX_LEN = 256
D_MIX = D_MODEL
POOL_WIDTH = D_MIX // 2
POOL_WINDOWS = (2, 4, 8, 16)
POOL_GROUP = POOL_WIDTH // len(POOL_WINDOWS)
GLA_WIDTH = D_MIX - POOL_WIDTH
GLA_HEADS = 4
GLA_DV = GLA_WIDTH // GLA_HEADS
GLA_DK = GLA_DV // 2
GLA_KW = GLA_HEADS * GLA_DK
GATE_RANK = 16
GATE_TAU = 16.0
GLA_CHUNK = 64
D_FF = 2816
N_MOD = 9
DN_ALPHA = (2.0 * DEPTH) ** 0.25
DN_BETA = (8.0 * DEPTH) ** -0.25
LN_EPS = 1e-6
IN_SPLITS = (POOL_WIDTH, GLA_KW, GLA_KW, GLA_WIDTH, GLA_WIDTH, GATE_RANK, GATE_RANK)
IN_COLS = sum(IN_SPLITS)

kernel_name = "hybrid_pool_gla_dit_trunk"


def _layernorm(x):
    x32 = x.astype(jnp.float32)
    mu = jnp.mean(x32, axis=-1, keepdims=True)
    var = jnp.mean(jnp.square(x32 - mu), axis=-1, keepdims=True)
    return ((x32 - mu) * lax.rsqrt(var + LN_EPS)).astype(x.dtype)


def _post_norm(x, y, g, b):
    z = (DN_ALPHA * x + y).astype(jnp.float32)
    mu = jnp.mean(z, axis=-1, keepdims=True)
    var = jnp.mean(jnp.square(z - mu), axis=-1, keepdims=True)
    return ((z - mu) * lax.rsqrt(var + LN_EPS) * g + b).astype(x.dtype)


def _modulate(h, shift, scale):
    return h * (1.0 + scale) + shift


def _ada(cond, w, b):
    m = jax.nn.silu(cond) @ w + b
    m = m.reshape(m.shape[:-1] + (N_MOD, D_MODEL))
    m = jnp.moveaxis(m, -2, 0)
    return m[..., None, :]


def _swiglu(h, w_in, w_out):
    g, u = jnp.split(h @ w_in, 2, axis=-1)
    return (jax.nn.silu(g) * u) @ w_out


def _pos_embed_2d(L, dtype):
    rows = L // GRID_W
    f32 = jnp.float32
    r = jnp.repeat(jnp.arange(rows, dtype=f32), GRID_W)
    col = jnp.tile(jnp.arange(GRID_W, dtype=f32), rows)
    quarter = D_MODEL // 4
    omega = 1.0 / (10000.0 ** (jnp.arange(quarter, dtype=f32) / quarter))

    def enc(p):
        a = p[:, None] * omega
        return jnp.concatenate([jnp.sin(a), jnp.cos(a)], axis=-1)

    return jnp.concatenate([enc(r), enc(col)], axis=-1).astype(dtype)


def _pool_mixer(u, pool_w, pool_scale):
    B, L, _ = u.shape
    u32 = u.astype(jnp.float32)
    cs = jnp.concatenate([jnp.zeros((B, 1, POOL_WIDTH), jnp.float32),
                          jnp.cumsum(u32, axis=1)], axis=1)
    t = jnp.arange(L)
    pooled = []
    for g, w in enumerate(POOL_WINDOWS):
        lo = jnp.maximum(t - w // 2, 0)
        hi = jnp.minimum(t + (w - 1 - w // 2), L - 1)
        csg = cs[:, :, g * POOL_GROUP:(g + 1) * POOL_GROUP]
        s = jnp.take(csg, hi + 1, axis=1) - jnp.take(csg, lo, axis=1)
        pooled.append(s / (hi - lo + 1).astype(jnp.float32)[None, :, None])
    pooled = jnp.stack(pooled, axis=2) - u32.reshape(B, L, len(POOL_WINDOWS), POOL_GROUP)
    y = jnp.einsum('blgc,gcd->blgd', pooled, pool_w.astype(jnp.float32))
    return (y.reshape(B, L, POOL_WIDTH) * pool_scale).astype(u.dtype)


def _project(h, w_in, gate_up_f, gate_bias_f, gate_up_b, gate_bias_b):
    B, L, _ = h.shape
    offs = tuple(int(o) for o in np.cumsum(IN_SPLITS)[:-1])
    u, q, k, v, r, gdf, gdb = jnp.split(h @ w_in, offs, axis=-1)

    def heads(t, d):
        return t.reshape(B, L, GLA_HEADS, d).transpose(0, 2, 1, 3)

    la_f = jax.nn.log_sigmoid((gdf @ gate_up_f + gate_bias_f).astype(jnp.float32)) / GATE_TAU
    la_b = jax.nn.log_sigmoid((gdb @ gate_up_b + gate_bias_b).astype(jnp.float32)) / GATE_TAU
    q = heads(q, GLA_DK) * (GLA_DK ** -0.5)
    return (u, q, heads(k, GLA_DK), heads(v, GLA_DV), r,
            heads(la_f, GLA_DK), heads(la_b, GLA_DK))


def _chunks(t):
    B, H, L, d = t.shape
    return t.reshape(B, H, L // GLA_CHUNK, GLA_CHUNK, d)


def _chunk_state_scan(kc, vc, b, S0):
    b_last = b[..., -1:, :]
    k_end = kc * jnp.exp(b_last - b)
    U = jnp.einsum('bhncd,bhnce->nbhde', k_end, vc)
    decay = jnp.moveaxis(jnp.exp(b_last[..., 0, :]), 2, 0)

    def step(S, inp):
        U_n, d_n = inp
        return d_n[..., None] * S + U_n, S

    S_fin, S_starts = lax.scan(step, S0, (U, decay))
    return S_starts, S_fin


def _gla_direction(q, k, v, log_a, S0):
    B, H, L, _ = v.shape
    f32 = jnp.float32
    qc, kc, vc = (_chunks(t.astype(f32)) for t in (q, k, v))
    b = jnp.cumsum(_chunks(log_a), axis=-2)
    S_starts, S_fin = _chunk_state_scan(kc, vc, b, S0)
    q_in = qc * jnp.exp(b)
    k_in = kc * jnp.exp(-b)
    lower = jnp.tril(jnp.ones((GLA_CHUNK, GLA_CHUNK), dtype=bool))
    scores = jnp.where(lower, jnp.einsum('bhnid,bhnjd->bhnij', q_in, k_in), 0.0)
    o = (jnp.einsum('bhnij,bhnje->bhnie', scores, vc)
         + jnp.einsum('bhnid,nbhde->bhnie', q_in, S_starts))
    return o.reshape(B, H, L, GLA_DV), S_fin


def _gla_final_state(k, v, log_a, S0):
    kc, vc = (_chunks(t.astype(jnp.float32)) for t in (k, v))
    b = jnp.cumsum(_chunks(log_a), axis=-2)
    _, S_fin = _chunk_state_scan(kc, vc, b, S0)
    return S_fin


def _gla_output(o, r, norm_g):
    B, H, L, dv = o.shape
    o = o.transpose(0, 2, 1, 3)
    o = o * lax.rsqrt(jnp.mean(jnp.square(o), axis=-1, keepdims=True) + LN_EPS)
    o = o.reshape(B, L, H * dv) * norm_g
    return (o * jax.nn.silu(r.astype(jnp.float32))).astype(r.dtype)


def _flip(t):
    return jnp.flip(t, axis=2)


def _mixer(h, hc, w_in, pool_w, pool_scale, gate_up_f, gate_bias_f, gate_up_b, gate_bias_b,
           norm_g, w_out, ctx_out):
    B = h.shape[0]
    gates = (gate_up_f, gate_bias_f, gate_up_b, gate_bias_b)
    u, q, k, v, r, la_f, la_b = _project(h, w_in, *gates)
    uc, qc, kc, vc, rc, lac_f, lac_b = _project(hc, w_in, *gates)
    S0 = jnp.zeros((B, GLA_HEADS, GLA_DK, GLA_DV), jnp.float32)
    yc = None
    if ctx_out:
        oc_f, S_f = _gla_direction(qc, kc, vc, lac_f, S0)
        oc_b, S_b = _gla_direction(_flip(qc), _flip(kc), _flip(vc), _flip(lac_b), S0)
        yc = jnp.concatenate([_pool_mixer(uc, pool_w, pool_scale),
                              _gla_output(oc_f + _flip(oc_b), rc, norm_g)], axis=-1) @ w_out
    else:
        S_f = _gla_final_state(kc, vc, lac_f, S0)
        S_b = _gla_final_state(_flip(kc), _flip(vc), _flip(lac_b), S0)
    o_f, _ = _gla_direction(q, k, v, la_f, S_f)
    o_b, _ = _gla_direction(_flip(q), _flip(k), _flip(v), _flip(la_b), S_b)
    y = jnp.concatenate([_pool_mixer(u, pool_w, pool_scale),
                         _gla_output(o_f + _flip(o_b), r, norm_g)], axis=-1) @ w_out
    return y, yc


def setup_inputs(seed: int = 0) -> dict:
    key = jax.random.key(seed)
    ks = jax.random.split(key, 24)
    f32 = jnp.float32

    def nrm(k, shape, s):
        return jax.random.normal(k, shape, f32) * s

    D = D_MODEL
    return {
        'x': nrm(ks[0], (BATCH, SEQ, D), 1.0),
        'c': nrm(ks[1], (BATCH, D), 1.0),
        'ctx': nrm(ks[2], (BATCH, CTX_LEN, D), 1.0),
        'c_ctx': nrm(ks[3], (D,), 1.0),
        'w_ada': nrm(ks[4], (DEPTH, D, N_MOD * D), 0.5 * D ** -0.5),
        'b_ada': nrm(ks[5], (DEPTH, N_MOD * D), 0.02),
        'ln_g': 1.0 + nrm(ks[6], (DEPTH, 3, D), 0.05),
        'ln_b': nrm(ks[7], (DEPTH, 3, D), 0.02),
        'ffa_w_in': nrm(ks[8], (DEPTH, D, 2 * D_FF), D ** -0.5),
        'ffa_w_out': nrm(ks[9], (DEPTH, D_FF, D), D_FF ** -0.5 * DN_BETA),
        'mix_w_in': nrm(ks[10], (DEPTH, D, IN_COLS), D ** -0.5),
        'pool_w': nrm(ks[11], (DEPTH, len(POOL_WINDOWS), POOL_GROUP, POOL_GROUP), POOL_GROUP ** -0.5),
        'pool_scale': 1.0 + nrm(ks[12], (DEPTH, POOL_WIDTH), 0.1),
        'gate_up_f': nrm(ks[13], (DEPTH, GATE_RANK, GLA_KW), GATE_RANK ** -0.5),
        'gate_bias_f': jax.random.uniform(ks[14], (DEPTH, GLA_KW), f32, 0.5, 3.0),
        'gate_up_b': nrm(ks[15], (DEPTH, GATE_RANK, GLA_KW), GATE_RANK ** -0.5),
        'gate_bias_b': jax.random.uniform(ks[16], (DEPTH, GLA_KW), f32, 0.5, 3.0),
        'gla_norm_g': 1.0 + nrm(ks[17], (DEPTH, GLA_WIDTH), 0.05),
        'mix_w_out': nrm(ks[18], (DEPTH, D_MIX, D), D_MIX ** -0.5 * DN_BETA),
        'ffb_w_in': nrm(ks[19], (DEPTH, D, 2 * D_FF), D ** -0.5),
        'ffb_w_out': nrm(ks[20], (DEPTH, D_FF, D), D_FF ** -0.5 * DN_BETA),
    }


def reference(x, c, ctx, c_ctx, w_ada, b_ada, ln_g, ln_b, ffa_w_in, ffa_w_out, mix_w_in,
              pool_w, pool_scale, gate_up_f, gate_bias_f, gate_up_b, gate_bias_b,
              gla_norm_g, mix_w_out, ffb_w_in, ffb_w_out):
    L = x.shape[1]
    h = _layernorm(x + _pos_embed_2d(L, x.dtype))
    hc = _layernorm(ctx)
    for l in range(DEPTH):
        last = l == DEPTH - 1
        mx = _ada(c, w_ada[l], b_ada[l])
        mc = _ada(c_ctx, w_ada[l], b_ada[l])
        h = _post_norm(h, 0.5 * mx[2] * _swiglu(_modulate(h, mx[0], mx[1]), ffa_w_in[l], ffa_w_out[l]),
                       ln_g[l, 0], ln_b[l, 0])
        hc = _post_norm(hc, 0.5 * mc[2] * _swiglu(_modulate(hc, mc[0], mc[1]), ffa_w_in[l], ffa_w_out[l]),
                        ln_g[l, 0], ln_b[l, 0])
        y, yc = _mixer(_modulate(h, mx[3], mx[4]), _modulate(hc, mc[3], mc[4]), mix_w_in[l],
                       pool_w[l], pool_scale[l], gate_up_f[l], gate_bias_f[l], gate_up_b[l],
                       gate_bias_b[l], gla_norm_g[l], mix_w_out[l], not last)
        h = _post_norm(h, mx[5] * y, ln_g[l, 1], ln_b[l, 1])
        h = _post_norm(h, 0.5 * mx[8] * _swiglu(_modulate(h, mx[6], mx[7]), ffb_w_in[l], ffb_w_out[l]),
                       ln_g[l, 2], ln_b[l, 2])
        if not last:
            hc = _post_norm(hc, mc[5] * yc, ln_g[l, 1], ln_b[l, 1])
            hc = _post_norm(hc, 0.5 * mc[8] * _swiglu(_modulate(hc, mc[6], mc[7]), ffb_w_in[l], ffb_w_out[l]),
                            ln_g[l, 2], ln_b[l, 2])
    return h
```

```cpp
#include <hip/hip_runtime.h>
#include <hip/hip_cooperative_groups.h>
#include <cstdio>
namespace cg = cooperative_groups;

#ifndef ONE_LAUNCH
#define ONE_LAUNCH 1
#endif

#define LAS __attribute__((address_space(3)))
typedef unsigned short bf16_t;
typedef short bf16x8 __attribute__((ext_vector_type(8)));
typedef float f32x4 __attribute__((ext_vector_type(4)));
typedef float f32x2 __attribute__((ext_vector_type(2)));
typedef unsigned u32x4 __attribute__((ext_vector_type(4)));
typedef unsigned u32x2 __attribute__((ext_vector_type(2)));

constexpr int D = 1024, NBATCH = 16, SEQ = 4096, CTXL = 256, DEPTH = 4, DFF = 2816, NMOD = 9;
constexpr int MLAT = NBATCH * SEQ, MCTX = NBATCH * CTXL, MTOT = MLAT + MCTX;
constexpr int NIN_SRC = 2080, NIN = 2304, NPROJ = 2048;
constexpr int NCHS = 68;
constexpr float DN_ALPHA = 1.6817928305074292f;
constexpr float LN_EPS = 1e-6f;
constexpr int NTHREADS = 512;

constexpr size_t WS_CTL = 0;
constexpr size_t WS_HC = 65536;
constexpr size_t WS_A = WS_HC + (size_t)MCTX * D * 4;
constexpr size_t WS_HID = WS_A + (size_t)MTOT * D * 2;
constexpr size_t WS_PROJ = WS_HID;
constexpr size_t WS_GD = WS_HID + (size_t)MTOT * NPROJ * 2;
constexpr size_t WS_UT = WS_HID + (size_t)MTOT * DFF * 2;
constexpr size_t SLOTS = (size_t)2 * NBATCH * 4 * NCHS;
constexpr size_t WS_ST = WS_UT + SLOTS * 8192 * 2;
constexpr size_t WS_DEC = WS_ST + SLOTS * 8192 * 2;
constexpr size_t WS_MOD = WS_DEC + SLOTS * 64 * 4;
constexpr size_t WS_TAB = WS_MOD + (size_t)DEPTH * 17 * NMOD * D * 4;
constexpr size_t WS_PW = WS_TAB + 64 * 512 * 4;
constexpr size_t WS_WFA1 = WS_PW + (size_t)DEPTH * 4 * 128 * 128 * 2;
constexpr size_t WS_WFA2 = WS_WFA1 + (size_t)DEPTH * 2 * DFF * D * 2;
constexpr size_t WS_WMI = WS_WFA2 + (size_t)DEPTH * D * DFF * 2;
constexpr size_t WS_WMO = WS_WMI + (size_t)DEPTH * NIN * D * 2;
constexpr size_t WS_WFB1 = WS_WMO + (size_t)DEPTH * D * D * 2;
constexpr size_t WS_WFB2 = WS_WFB1 + (size_t)DEPTH * 2 * DFF * D * 2;
constexpr size_t WS_END = WS_WFB2 + (size_t)DEPTH * D * DFF * 2;
static_assert(WS_END <= (size_t)1073741824, "workspace too large");
static_assert((size_t)MTOT * NPROJ * 2 + (size_t)MTOT * 32 * 4 <= (size_t)MTOT * DFF * 2, "proj alias");

constexpr int LDS_BYTES = 155648;

typedef __bf16 nbf16x2 __attribute__((ext_vector_type(2)));
__device__ __forceinline__ unsigned cvt_pk_bf16(float lo, float hi) { const f32x2 f = {lo, hi}; const nbf16x2 v = __builtin_convertvector(f, nbf16x2); return __builtin_bit_cast(unsigned, v); }
__device__ __forceinline__ float bf2f(unsigned short b) { return __uint_as_float(((unsigned)b) << 16); }
__device__ __forceinline__ float bflo(unsigned w) { return __uint_as_float(w << 16); }
__device__ __forceinline__ float bfhi(unsigned w) { return __uint_as_float(w & 0xffff0000u); }
__device__ __forceinline__ unsigned short f2bf(float f) { return __builtin_bit_cast(unsigned short, (__bf16)f); }
__device__ __forceinline__ float silu_f(float x) { return x / (1.0f + __expf(-x)); }
__device__ __forceinline__ int opaque_tid() { int t = threadIdx.x; asm volatile("" : "+v"(t)); return t; }
__device__ __forceinline__ float wave_sum(float v) {
#pragma unroll
    for (int o = 1; o < 64; o <<= 1) v += __shfl_xor(v, o);
    return v;
}

namespace pg8 {
constexpr int BM = 256, BK = 64, HALF = 128, HTB = HALF * BK * 2, STAGE_BYTES = 8 * HTB, NXCD = 8, WGM = 8;
__host__ __device__ __forceinline__ int lds_byte(int r, int c) { const int st = (r >> 4) * 2 + (c >> 5), rr = r & 15, cc = c & 31, ob = rr * 64 + cc * 2; return st * 1024 + (ob ^ (((ob >> 9) & 1) << 5)); }
__host__ __device__ __forceinline__ void stage_rc(int b, int& R, int& C) { const int st = b / 1024, sb = b % 1024, swz = sb ^ (((sb >> 9) & 1) << 5); R = (st >> 1) * 16 + swz / 64; C = (st & 1) * 32 + (swz % 64) / 2; }

struct Unit { int pm, pn; };
struct Gemm { const bf16_t* A; const bf16_t* Bt; int M, N, K; };

struct StaticOrder {
    int nM, nN, nwg, G, c;
    __device__ void init(int M, int N, int G_, int c_) { nM = M / BM; nN = N / BM; nwg = nM * nN; G = G_; c = c_; }
    __device__ bool next(int i, Unit& u) const {
        const long L = (long)i * G + c; if (L >= nwg) return false;
        int wgid = (int)L; { const int q = nwg / NXCD, r = nwg % NXCD, xcd = wgid % NXCD, off = wgid / NXCD; wgid = (xcd < r ? xcd * (q + 1) : r * (q + 1) + (xcd - r) * q) + off; }
        const int nig = WGM * nN, gid = wgid / nig, fm = gid * WGM, gsz = (nM - fm) < WGM ? (nM - fm) : WGM;
        u.pm = fm + ((wgid % nig) % gsz); u.pn = (wgid % nig) / gsz; return true;
    }
};

template <class Epi>
__device__ __forceinline__ void gemm_phase(LAS unsigned char* lds, const Gemm g, const StaticOrder& S, const Epi& E) {
    const int tid = opaque_tid(), wid = __builtin_amdgcn_readfirstlane(tid >> 6), lane = tid & 63, wr = wid >> 2, wc = wid & 3, fr = lane & 15, fq = lane >> 4;
    const int K = g.K, nt = K / BK;
    unsigned voffA[2];
#pragma unroll
    for (int i = 0; i < 2; ++i) { int R, C; stage_rc(tid * 16 + i * 8192, R, C); voffA[i] = (unsigned)(R * K + C) * 2u; }
    const size_t kstep = (size_t)(BK * 2);
    const size_t hstep = (size_t)HALF * K * 2;
    const size_t tstep = 2 * hstep;
    const unsigned ldsw = (unsigned)wid * 1024u;
    const int aoff = lds_byte(wr * 64 + fr, fq * 8), boff = lds_byte(wc * 32 + fr, fq * 8);
#define PG8_SA(b, h) (((b) * 2 + (h)) * HTB)
#define PG8_SB(b, h) ((4 + (b) * 2 + (h)) * HTB)
#define PG8_STAGE(bufoff, gbase) do { _Pragma("unroll") for (int _i = 0; _i < 2; ++_i) \
        __builtin_amdgcn_global_load_lds((const unsigned*)((const char*)(gbase) + voffA[_i]), (LAS unsigned*)(lds + (bufoff) + ldsw + _i * 8192), 16, 0, 0); } while (0)
#define PG8_LDA(dst, b, h) do { _Pragma("unroll") for (int m = 0; m < 4; ++m) _Pragma("unroll") for (int k = 0; k < 2; ++k) dst[m][k] = *(const LAS bf16x8*)(lds + PG8_SA(b, h) + aoff + m * 2048 + k * 1024); } while (0)
#define PG8_LDB(dst, b, h) do { _Pragma("unroll") for (int n = 0; n < 2; ++n) _Pragma("unroll") for (int k = 0; k < 2; ++k) dst[n][k] = *(const LAS bf16x8*)(lds + PG8_SB(b, h) + boff + n * 2048 + k * 1024); } while (0)
#define PG8_MMA(ai, bj, At, Bt) do { __builtin_amdgcn_s_setprio(1); _Pragma("unroll") for (int m = 0; m < 4; ++m) _Pragma("unroll") for (int n = 0; n < 2; ++n) _Pragma("unroll") for (int k = 0; k < 2; ++k) \
        acc[ai][bj][m][n] = __builtin_amdgcn_mfma_f32_16x16x32_bf16(Bt[n][k], At[m][k], acc[ai][bj][m][n], 0, 0, 0); __builtin_amdgcn_s_setprio(0); } while (0)
#define PG8_WAIT_V(n) asm volatile("s_waitcnt vmcnt(" #n ")" ::: "memory")
#define PG8_WAIT_L(n) asm volatile("s_waitcnt lgkmcnt(" #n ")" ::: "memory")
#define PG8_BAR __builtin_amdgcn_s_barrier()
#define PG8_SCHED __builtin_amdgcn_sched_barrier(0)
    Unit cur, nxt; int ui = 0;
    if (!S.next(0, cur)) return;
    f32x4 acc[2][2][4][2];
#pragma unroll
    for (int a = 0; a < 2; ++a)
#pragma unroll
        for (int b = 0; b < 2; ++b)
#pragma unroll
            for (int m = 0; m < 4; ++m)
#pragma unroll
                for (int n = 0; n < 2; ++n) acc[a][b][m][n] = (f32x4){0.f, 0.f, 0.f, 0.f};
    bf16x8 At[4][2], B0[2][2], B1[2][2];
    const char* cA = (const char*)g.A + (size_t)cur.pm * tstep; const char* cB = (const char*)g.Bt + (size_t)cur.pn * tstep;
    PG8_STAGE(PG8_SB(0, 0), cB); PG8_STAGE(PG8_SA(0, 0), cA); PG8_STAGE(PG8_SB(0, 1), cB + hstep); PG8_STAGE(PG8_SA(0, 1), cA + hstep);
    if (wr == 1) PG8_BAR;
    PG8_WAIT_V(4); PG8_BAR;
    PG8_STAGE(PG8_SB(1, 0), cB + kstep); PG8_STAGE(PG8_SA(1, 0), cA + kstep); PG8_STAGE(PG8_SB(1, 1), cB + hstep + kstep);
    PG8_WAIT_V(6); PG8_BAR;
    for (;;) {
        const bool has_next = S.next(ui + 1, nxt);
        const char* nA = has_next ? (const char*)g.A + (size_t)nxt.pm * tstep : cA; const char* nB = has_next ? (const char*)g.Bt + (size_t)nxt.pn * tstep : cB;
        for (int t = 0; t < nt; t += 2) {
            const bool last = (t == nt - 2);
            const char* a1 = cA + (size_t)(t + 1) * kstep;
            const char* a2 = last ? nA : cA + (size_t)(t + 2) * kstep; const char* b2 = last ? nB : cB + (size_t)(t + 2) * kstep;
            const char* a3 = a2 + kstep; const char* b3 = b2 + kstep;
            PG8_LDB(B0, 0, 0); PG8_SCHED; PG8_LDA(At, 0, 0); PG8_STAGE(PG8_SA(1, 1), a1 + hstep);
            PG8_WAIT_L(8); PG8_BAR; PG8_WAIT_L(0); PG8_MMA(0, 0, At, B0); PG8_BAR; PG8_SCHED;
            PG8_LDB(B1, 0, 1); PG8_STAGE(PG8_SB(0, 0), b2);
            PG8_BAR; PG8_WAIT_L(0); PG8_MMA(0, 1, At, B1); PG8_BAR;
            PG8_LDA(At, 0, 1); PG8_STAGE(PG8_SA(0, 0), a2);
            PG8_BAR; PG8_WAIT_L(0); PG8_MMA(1, 0, At, B0); PG8_BAR; PG8_SCHED;
            PG8_STAGE(PG8_SB(0, 1), b2 + hstep);
            PG8_WAIT_V(6); PG8_BAR; PG8_MMA(1, 1, At, B1); PG8_BAR;
            PG8_LDB(B0, 1, 0); PG8_SCHED; PG8_LDA(At, 1, 0); PG8_STAGE(PG8_SA(0, 1), a2 + hstep);
            PG8_WAIT_L(8); PG8_BAR; PG8_WAIT_L(0); PG8_MMA(0, 0, At, B0); PG8_BAR; PG8_SCHED;
            PG8_LDB(B1, 1, 1); PG8_STAGE(PG8_SB(1, 0), b3);
            PG8_BAR; PG8_WAIT_L(0); PG8_MMA(0, 1, At, B1); PG8_BAR;
            PG8_LDA(At, 1, 1); PG8_STAGE(PG8_SA(1, 0), a3);
            PG8_BAR; PG8_WAIT_L(0); PG8_MMA(1, 0, At, B0); PG8_BAR; PG8_SCHED;
            PG8_STAGE(PG8_SB(1, 1), b3 + hstep);
            PG8_WAIT_V(6); PG8_BAR; PG8_MMA(1, 1, At, B1); PG8_BAR;
        }
        E(acc, cur, wr, wc, fr, fq);
        if (!has_next) break;
#pragma unroll
        for (int a = 0; a < 2; ++a)
#pragma unroll
            for (int b = 0; b < 2; ++b)
#pragma unroll
                for (int m = 0; m < 4; ++m)
#pragma unroll
                    for (int n = 0; n < 2; ++n) acc[a][b][m][n] = (f32x4){0.f, 0.f, 0.f, 0.f};
        cur = nxt; cA = nA; cB = nB; ++ui;
    }
    PG8_WAIT_V(0);
    if (wr == 0) PG8_BAR;
    PG8_BAR;
#undef PG8_SA
#undef PG8_SB
#undef PG8_STAGE
#undef PG8_LDA
#undef PG8_LDB
#undef PG8_MMA
#undef PG8_WAIT_V
#undef PG8_WAIT_L
#undef PG8_BAR
#undef PG8_SCHED
}
}

struct EpiSwiglu {
    bf16_t* H;
    __device__ __forceinline__ void operator()(const f32x4 (&acc)[2][2][4][2], const pg8::Unit& u, int wr, int wc, int fr, int fq) const {
        const int row0 = u.pm * 256 + wr * 64 + fr, hc0 = u.pn * 128 + wc * 16 + 4 * fq;
#pragma unroll
        for (int ai = 0; ai < 2; ++ai)
#pragma unroll
            for (int m = 0; m < 4; ++m) { bf16_t* rowp = H + (size_t)(row0 + ai * 128 + m * 16) * DFF + hc0;
#pragma unroll
                for (int bj = 0; bj < 2; ++bj) { const f32x4 gg = acc[ai][bj][m][0], uu = acc[ai][bj][m][1];
                    u32x2 w; w.x = cvt_pk_bf16(silu_f(gg[0]) * uu[0], silu_f(gg[1]) * uu[1]); w.y = cvt_pk_bf16(silu_f(gg[2]) * uu[2], silu_f(gg[3]) * uu[3]);
                    *(u32x2*)(rowp + bj * 64) = w; } }
    }
};
struct EpiResid {
    float* lat; float* ctx; const float* gate; float gs;
    __device__ __forceinline__ void operator()(const f32x4 (&acc)[2][2][4][2], const pg8::Unit& u, int wr, int wc, int fr, int fq) const {
        const int row0 = u.pm * 256 + wr * 64 + fr, col0 = u.pn * 256 + wc * 32 + 4 * fq;
        const int grp = (u.pm < 256) ? (u.pm >> 4) : 16;
        f32x4 gv[2][2];
#pragma unroll
        for (int bj = 0; bj < 2; ++bj)
#pragma unroll
            for (int n = 0; n < 2; ++n) gv[bj][n] = *(const f32x4*)(gate + (size_t)grp * (NMOD * D) + col0 + bj * 128 + n * 16) * gs;
#pragma unroll
        for (int ai = 0; ai < 2; ++ai)
#pragma unroll
            for (int m = 0; m < 4; ++m) { const int r = row0 + ai * 128 + m * 16;
                float* rowp = (r < MLAT ? lat + (size_t)r * D : ctx + (size_t)(r - MLAT) * D) + col0;
#pragma unroll
                for (int bj = 0; bj < 2; ++bj)
#pragma unroll
                    for (int n = 0; n < 2; ++n) { const f32x4 h = *(const f32x4*)(rowp + bj * 128 + n * 16); *(f32x4*)(rowp + bj * 128 + n * 16) = h * DN_ALPHA + gv[bj][n] * acc[ai][bj][m][n]; }
                asm volatile("" ::: "memory"); }
    }
};
struct EpiMixIn {
    bf16_t* P; float* GDp;
    __device__ __forceinline__ void operator()(const f32x4 (&acc)[2][2][4][2], const pg8::Unit& u, int wr, int wc, int fr, int fq) const {
        const int row0 = u.pm * 256 + wr * 64 + fr;
        if (u.pn < 8) {
            const int col0 = u.pn * 256 + wc * 32 + 4 * fq;
#pragma unroll
            for (int ai = 0; ai < 2; ++ai)
#pragma unroll
                for (int m = 0; m < 4; ++m) { bf16_t* rowp = P + (size_t)(row0 + ai * 128 + m * 16) * NPROJ + col0;
#pragma unroll
                    for (int bj = 0; bj < 2; ++bj)
#pragma unroll
                        for (int n = 0; n < 2; ++n) { const f32x4 v = acc[ai][bj][m][n]; u32x2 w; w.x = cvt_pk_bf16(v[0], v[1]); w.y = cvt_pk_bf16(v[2], v[3]); *(u32x2*)(rowp + bj * 128 + n * 16) = w; } }
        } else if (wc == 0) {
#pragma unroll
            for (int ai = 0; ai < 2; ++ai)
#pragma unroll
                for (int m = 0; m < 4; ++m) { float* rowp = GDp + (size_t)(row0 + ai * 128 + m * 16) * 32 + 4 * fq;
#pragma unroll
                    for (int n = 0; n < 2; ++n) *(f32x4*)(rowp + n * 16) = acc[ai][0][m][n]; }
        }
    }
};

struct Params {
    const float *x, *c, *ctx, *c_ctx, *w_ada, *b_ada, *ln_g, *ln_b, *ffa_w_in, *ffa_w_out, *mix_w_in, *pool_w, *pool_scale,
                *gate_up_f, *gate_bias_f, *gate_up_b, *gate_bias_b, *gla_norm_g, *mix_w_out, *ffb_w_in, *ffb_w_out;
    float* out; unsigned char* ws;
    int ph_lo, ph_hi;
};

__device__ __forceinline__ int srccol(int mode, int R, int Nsrc) {
    if (mode == 0) return R;
    if (mode == 1) { const int pn = R >> 8, cc = R & 255, grp = cc >> 5, isu = (cc >> 4) & 1, w = cc & 15; return isu * DFF + pn * 128 + grp * 16 + w; }
    return R < Nsrc ? R : -1;
}
__device__ __forceinline__ void transpose_tile(const float* W, int K, int Nsrc, bf16_t* Wt, int mode, int kb, int rb, LAS float* scr) {
    const int tid = opaque_tid(), nn = tid & 63, k0 = kb * 64, R0 = rb * 64;
    const int sc = srccol(mode, R0 + nn, Nsrc);
#pragma unroll
    for (int i = 0; i < 8; ++i) { const int kk = (tid >> 6) + 8 * i; scr[kk * 65 + nn] = sc >= 0 ? W[(size_t)(k0 + kk) * Nsrc + sc] : 0.f; }
    __syncthreads();
    { const int n = tid >> 3, c8 = tid & 7; const LAS float* s = scr + (8 * c8) * 65 + n;
      u32x4 o; o.x = cvt_pk_bf16(s[0], s[65]); o.y = cvt_pk_bf16(s[2 * 65], s[3 * 65]); o.z = cvt_pk_bf16(s[4 * 65], s[5 * 65]); o.w = cvt_pk_bf16(s[6 * 65], s[7 * 65]);
      *(u32x4*)(Wt + (size_t)(R0 + n) * K + k0 + 8 * c8) = o; }
    __syncthreads();
}
__device__ __forceinline__ void convert_weight(const float* W, int K, int Nsrc, int Ndst, bf16_t* Wt, int mode, LAS float* scr, int& base) {
    const int G = gridDim.x, nrb = Ndst / 64, cnt = (K / 64) * nrb;
    const int first = (int)(((long)blockIdx.x + (long)G * 1024 - base) % G);
    for (int it = first; it < cnt; it += G) transpose_tile(W, K, Nsrc, Wt, mode, it / nrb, it % nrb, scr);
    base = (base + cnt) % G;
}

__device__ __forceinline__ void phase0a(const Params& p, LAS unsigned char* lds) {
    const int tid = opaque_tid(), lane = tid & 63, w = tid >> 6, G = gridDim.x;
    unsigned char* ws = p.ws;
    {
        LAS float* sc = (LAS float*)lds;
        LAS float* part = (LAS float*)(lds + 69632);
        float* mod = (float*)(ws + WS_MOD);
        if ((int)blockIdx.x < DEPTH * 144) {
            for (int idx = tid; idx < 17 * 1024; idx += NTHREADS) { const int g = idx >> 10, i = idx & 1023; const float v = g < 16 ? p.c[g * 1024 + i] : p.c_ctx[i]; sc[idx] = silu_f(v); }
            __syncthreads();
            for (int unit = blockIdx.x; unit < DEPTH * 144; unit += G) {
                const int l = unit / 144, jb = unit % 144;
                float acc[17];
#pragma unroll
                for (int g = 0; g < 17; ++g) acc[g] = 0.f;
                const float* wp = p.w_ada + ((size_t)l * 1024 + w * 128) * (NMOD * D) + jb * 64 + lane;
#pragma unroll 4
                for (int i = 0; i < 128; ++i) { const float wv = wp[(size_t)i * (NMOD * D)];
#pragma unroll
                    for (int g = 0; g < 17; ++g) acc[g] += sc[g * 1024 + w * 128 + i] * wv; }
#pragma unroll
                for (int g = 0; g < 17; ++g) part[(w * 17 + g) * 64 + lane] = acc[g];
                __syncthreads();
                for (int idx = tid; idx < 17 * 64; idx += NTHREADS) { const int g = idx >> 6, jj = idx & 63; float s = 0.f;
#pragma unroll
                    for (int ww = 0; ww < 8; ++ww) s += part[(ww * 17 + g) * 64 + jj];
                    mod[((size_t)l * 17 + g) * (NMOD * D) + jb * 64 + jj] = s + p.b_ada[l * (NMOD * D) + jb * 64 + jj]; }
                __syncthreads();
            }
        }
    }
    {
        float* tab = (float*)(ws + WS_TAB);
        for (int idx = blockIdx.x * NTHREADS + tid; idx < 64 * 256; idx += G * NTHREADS) {
            const int pp = idx >> 8, i = idx & 255;
            const float omega = 1.0f / expf(9.210340371976184f * ((float)i / 256.0f));
            const float a = (float)pp * omega;
            const double ad = (double)a; const double kq = rint(ad * 0.6366197723675814);
            double r = fma(-kq, 1.5707963267948966, ad); r = fma(-kq, 6.123233995736766e-17, r);
            const int q = ((int)kq) & 3; const double r2 = r * r;
            const double sr = r * (1.0 + r2 * (-1.0 / 6 + r2 * (1.0 / 120 + r2 * (-1.0 / 5040 + r2 * (1.0 / 362880 + r2 * (-1.0 / 39916800 + r2 * (1.0 / 6227020800.0)))))));
            const double cr = 1.0 + r2 * (-0.5 + r2 * (1.0 / 24 + r2 * (-1.0 / 720 + r2 * (1.0 / 40320 + r2 * (-1.0 / 3628800 + r2 * (1.0 / 479001600 + r2 * (-1.0 / 87178291200.0)))))));
            double s, c;
            if (q == 0) { s = sr; c = cr; } else if (q == 1) { s = cr; c = -sr; } else if (q == 2) { s = -sr; c = -cr; } else { s = -cr; c = sr; }
            tab[pp * 512 + i] = (float)s; tab[pp * 512 + 256 + i] = (float)c;
        }
    }
    {
        LAS float* scr = (LAS float*)lds;
        int base = 0;
        for (int l = 0; l < DEPTH; ++l) {
            convert_weight(p.ffa_w_in + (size_t)l * D * 2 * DFF, D, 2 * DFF, 2 * DFF, (bf16_t*)(ws + WS_WFA1) + (size_t)l * 2 * DFF * D, 1, scr, base);
            convert_weight(p.ffb_w_in + (size_t)l * D * 2 * DFF, D, 2 * DFF, 2 * DFF, (bf16_t*)(ws + WS_WFB1) + (size_t)l * 2 * DFF * D, 1, scr, base);
            convert_weight(p.ffa_w_out + (size_t)l * DFF * D, DFF, D, D, (bf16_t*)(ws + WS_WFA2) + (size_t)l * D * DFF, 0, scr, base);
            convert_weight(p.ffb_w_out + (size_t)l * DFF * D, DFF, D, D, (bf16_t*)(ws + WS_WFB2) + (size_t)l * D * DFF, 0, scr, base);
            convert_weight(p.mix_w_in + (size_t)l * D * NIN_SRC, D, NIN_SRC, NIN, (bf16_t*)(ws + WS_WMI) + (size_t)l * NIN * D, 2, scr, base);
            convert_weight(p.mix_w_out + (size_t)l * D * D, D, D, D, (bf16_t*)(ws + WS_WMO) + (size_t)l * D * D, 0, scr, base);
            for (int g = 0; g < 4; ++g)
                convert_weight(p.pool_w + (size_t)(l * 4 + g) * 128 * 128, 128, 128, 128, (bf16_t*)(ws + WS_PW) + (size_t)(l * 4 + g) * 128 * 128, 0, scr, base);
        }
    }
}

__device__ __forceinline__ void ln_phase(const float* src_lat, const float* src_ctx, float* dst_lat, float* dst_ctx, bf16_t* A,
                                         const float* gam, const float* bet, const float* tab, const float* modl, int ish, int isc) {
    const int tid = opaque_tid(), lane = tid & 63, w = tid >> 6;
    const int gw = blockIdx.x * 8 + w, NGW = gridDim.x * 8;
    for (int blk = gw; blk < MTOT / 16; blk += NGW) {
        const int r0 = blk * 16;
        const int grp = r0 < MLAT ? (r0 >> 12) : 16;
        f32x4 gv[4], bv[4], shv[4], scv[4];
#pragma unroll
        for (int j = 0; j < 4; ++j) { const int col = 4 * lane + 256 * j;
            gv[j] = gam ? *(const f32x4*)(gam + col) : (f32x4){1.f, 1.f, 1.f, 1.f};
            bv[j] = bet ? *(const f32x4*)(bet + col) : (f32x4){0.f, 0.f, 0.f, 0.f};
            if (modl) { shv[j] = *(const f32x4*)(modl + (size_t)grp * (NMOD * D) + ish * D + col); scv[j] = *(const f32x4*)(modl + (size_t)grp * (NMOD * D) + isc * D + col) + 1.0f; }
            else { shv[j] = (f32x4){0.f, 0.f, 0.f, 0.f}; scv[j] = (f32x4){1.f, 1.f, 1.f, 1.f}; } }
        for (int rr = 0; rr < 16; ++rr) {
            const int r = r0 + rr;
            const float* sp = r < MLAT ? src_lat + (size_t)r * D : src_ctx + (size_t)(r - MLAT) * D;
            float* dp = r < MLAT ? dst_lat + (size_t)r * D : dst_ctx + (size_t)(r - MLAT) * D;
            f32x4 v[4]; float s = 0.f;
#pragma unroll
            for (int j = 0; j < 4; ++j) v[j] = *(const f32x4*)(sp + 4 * lane + 256 * j);
            if (tab && r < MLAT) { const int t = r & (SEQ - 1), prow = t >> 6, pcol = t & 63;
#pragma unroll
                for (int j = 0; j < 4; ++j) { const int col = 4 * lane + 256 * j; v[j] += (j < 2) ? *(const f32x4*)(tab + prow * 512 + col) : *(const f32x4*)(tab + pcol * 512 + col - 512); } }
#pragma unroll
            for (int j = 0; j < 4; ++j) s += (v[j][0] + v[j][1]) + (v[j][2] + v[j][3]);
            const float mean = wave_sum(s) * (1.0f / D); float s2 = 0.f;
#pragma unroll
            for (int j = 0; j < 4; ++j) { v[j] = v[j] - mean; s2 += (v[j][0] * v[j][0] + v[j][1] * v[j][1]) + (v[j][2] * v[j][2] + v[j][3] * v[j][3]); }
            const float rstd = 1.0f / sqrtf(wave_sum(s2) * (1.0f / D) + LN_EPS);
#pragma unroll
            for (int j = 0; j < 4; ++j) { const f32x4 h = v[j] * rstd * gv[j] + bv[j]; *(f32x4*)(dp + 4 * lane + 256 * j) = h;
                if (modl) { const f32x4 a = h * scv[j] + shv[j]; u32x2 o; o.x = cvt_pk_bf16(a[0], a[1]); o.y = cvt_pk_bf16(a[2], a[3]); *(u32x2*)(A + (size_t)r * D + 4 * lane + 256 * j) = o; } }
        }
    }
}

constexpr int L_BF = 0, L_BB = 16384, L_GD = 32768, L_TOT = 40960, L_PART = 43008, L_QF = 45056, L_KF = 54272, L_QB = 63488, L_KB = 72704,
              L_PF = 81920, L_PB = 91136, L_VT = 100352, L_SF = 118784, L_SB = 137216;
constexpr int L_GU = L_PF, L_BIAS = L_PB;
constexpr int L_UW = 0, L_POOLED = L_QF, L_PWT = L_QB;
constexpr int LDT = 72, LDP = 136;
static_assert(L_SB + 128 * LDT * 2 <= LDS_BYTES, "lds");

__device__ __forceinline__ f32x4 mma_lds(const LAS bf16_t* A, const LAS bf16_t* B, int lda, int ldb, int K, f32x4 acc, int fr, int fq) {
    for (int k0 = 0; k0 < K; k0 += 32) {
        const bf16x8 a = *(const LAS bf16x8*)(A + fr * lda + k0 + fq * 8);
        const bf16x8 b = *(const LAS bf16x8*)(B + fr * ldb + k0 + fq * 8);
        acc = __builtin_amdgcn_mfma_f32_16x16x32_bf16(a, b, acc, 0, 0, 0);
    }
    return acc;
}

struct GUnit { int b, n, isctx, h, row0, slot_f, slot_b, seq0, seqlen; };
__device__ __forceinline__ GUnit decode_unit(int u) {
    GUnit g; g.h = u & 3; const int cn = u >> 2;
    if (cn < 1024) { g.b = cn >> 6; g.n = cn & 63; g.isctx = 0; g.row0 = g.b * SEQ + g.n * 64; g.seq0 = g.b * SEQ; g.seqlen = SEQ;
        g.slot_f = ((0 * 16 + g.b) * 4 + g.h) * NCHS + 4 + g.n; g.slot_b = ((16 + g.b) * 4 + g.h) * NCHS + 4 + (63 - g.n); }
    else { const int c2 = cn - 1024; g.b = c2 >> 2; g.n = c2 & 3; g.isctx = 1; g.row0 = MLAT + g.b * CTXL + g.n * 64; g.seq0 = MLAT + g.b * CTXL; g.seqlen = CTXL;
        g.slot_f = ((0 * 16 + g.b) * 4 + g.h) * NCHS + g.n; g.slot_b = ((16 + g.b) * 4 + g.h) * NCHS + (3 - g.n); }
    return g;
}

__device__ __forceinline__ void compute_decay(const Params& p, int l, const GUnit& g, LAS unsigned char* lds) {
    const int tid = opaque_tid();
    const float* GDp = (const float*)(p.ws + WS_GD);
    LAS float* bF = (LAS float*)(lds + L_BF); LAS float* bB = (LAS float*)(lds + L_BB); LAS float* gd = (LAS float*)(lds + L_GD);
    LAS float* tot = (LAS float*)(lds + L_TOT); LAS float* gu = (LAS float*)(lds + L_GU); LAS float* bias = (LAS float*)(lds + L_BIAS);
    { const int row = tid >> 3, c4 = (tid & 7) * 4; *(LAS f32x4*)(gd + row * 32 + c4) = *(const f32x4*)(GDp + (size_t)(g.row0 + row) * 32 + c4); }
    {
      const int dir = tid >> 8, r = (tid >> 4) & 15, c4 = (tid & 15) * 4;
      const float* src = (dir ? p.gate_up_b : p.gate_up_f) + (size_t)l * 16 * 256 + r * 256 + g.h * 64 + c4;
      *(LAS f32x4*)(gu + dir * 1024 + r * 64 + c4) = *(const f32x4*)src;
      if (tid < 128) { const int dr = tid >> 6, dd = tid & 63; bias[tid] = (dr ? p.gate_bias_b : p.gate_bias_f)[l * 256 + g.h * 64 + dd]; } }
    __syncthreads();
    { const int t = tid >> 3, d0 = (tid & 7) * 8;
#pragma unroll
      for (int dir = 0; dir < 2; ++dir) {
          float z[8];
#pragma unroll
          for (int dd = 0; dd < 8; ++dd) z[dd] = bias[dir * 64 + d0 + dd];
#pragma unroll
          for (int r = 0; r < 16; ++r) { const float gv = gd[t * 32 + dir * 16 + r];
#pragma unroll
              for (int dd = 0; dd < 8; ++dd) z[dd] += gv * gu[dir * 1024 + r * 64 + d0 + dd]; }
          LAS float* dst = (dir ? bB : bF) + t * 64 + d0;
#pragma unroll
          for (int dd = 0; dd < 8; ++dd) { const float zz = z[dd]; const float ls = fminf(zz, 0.f) - __logf(1.0f + __expf(-fabsf(zz))); dst[dd] = ls * (1.0f / 16.0f); }
      } }
    __syncthreads();
    const int c = tid & 127, dir = c >> 6, d = c & 63, seg = tid >> 7;
    LAS float* col = (dir ? bB : bF) + d;
    { float run = 0.f;
      if (dir == 0) { for (int i = 0; i < 16; ++i) { const int t = seg * 16 + i; run += col[t * 64]; col[t * 64] = run; } }
      else { for (int i = 0; i < 16; ++i) { const int t = 63 - seg * 16 - i; run += col[t * 64]; col[t * 64] = run; } }
      tot[seg * 128 + c] = run; }
    __syncthreads();
    { float off = 0.f;
      for (int s = 0; s < seg; ++s) off += tot[s * 128 + c];
      if (seg > 0) { if (dir == 0) { for (int i = 0; i < 16; ++i) { const int t = seg * 16 + i; col[t * 64] += off; } }
                     else { for (int i = 0; i < 16; ++i) { const int t = 63 - seg * 16 - i; col[t * 64] += off; } } } }
    __syncthreads();
}
__device__ __forceinline__ void stage_vT(const Params& p, const GUnit& g, LAS unsigned char* lds) {
    const int tid = opaque_tid(), lane = tid & 63, w = tid >> 6;
    const bf16_t* P = (const bf16_t*)(p.ws + WS_PROJ);
    LAS bf16_t* vT = (LAS bf16_t*)(lds + L_VT);
#pragma unroll
    for (int i = 0; i < 2; ++i) { const int e0 = 8 * (w + 8 * i);
        const u32x4 v8 = *(const u32x4*)(P + (size_t)(g.row0 + lane) * NPROJ + 1024 + g.h * 128 + e0);
        vT[(e0 + 0) * LDT + lane] = (bf16_t)(v8.x & 0xffff); vT[(e0 + 1) * LDT + lane] = (bf16_t)(v8.x >> 16);
        vT[(e0 + 2) * LDT + lane] = (bf16_t)(v8.y & 0xffff); vT[(e0 + 3) * LDT + lane] = (bf16_t)(v8.y >> 16);
        vT[(e0 + 4) * LDT + lane] = (bf16_t)(v8.z & 0xffff); vT[(e0 + 5) * LDT + lane] = (bf16_t)(v8.z >> 16);
        vT[(e0 + 6) * LDT + lane] = (bf16_t)(v8.w & 0xffff); vT[(e0 + 7) * LDT + lane] = (bf16_t)(v8.w >> 16); }
}

__device__ __forceinline__ void g1_phase(const Params& p, int l, LAS unsigned char* lds) {
    const int tid = opaque_tid(), lane = tid & 63, w = tid >> 6, fr = lane & 15, fq = lane >> 4;
    const bf16_t* P = (const bf16_t*)(p.ws + WS_PROJ);
    bf16_t* UT = (bf16_t*)(p.ws + WS_UT); float* DEC = (float*)(p.ws + WS_DEC);
    LAS float* bF = (LAS float*)(lds + L_BF); LAS float* bB = (LAS float*)(lds + L_BB);
    LAS bf16_t* keF = (LAS bf16_t*)(lds + L_KF); LAS bf16_t* keB = (LAS bf16_t*)(lds + L_KB); LAS bf16_t* vT = (LAS bf16_t*)(lds + L_VT);
    for (int u = blockIdx.x; u < 4352; u += gridDim.x) {
        const GUnit g = decode_unit(u);
        const int t = tid >> 3, d0 = (tid & 7) * 8;
        const u32x4 k8 = *(const u32x4*)(P + (size_t)(g.row0 + t) * NPROJ + 768 + g.h * 64 + d0);
        stage_vT(p, g, lds);
        compute_decay(p, l, g, lds);
        { float kf[8] = {bflo(k8.x), bfhi(k8.x), bflo(k8.y), bfhi(k8.y), bflo(k8.z), bfhi(k8.z), bflo(k8.w), bfhi(k8.w)};
#pragma unroll
          for (int dd = 0; dd < 8; ++dd) { const int d = d0 + dd;
              keF[d * LDT + t] = f2bf(kf[dd] * __expf(bF[63 * 64 + d] - bF[t * 64 + d]));
              keB[d * LDT + t] = f2bf(kf[dd] * __expf(bB[d] - bB[t * 64 + d])); }
          if (tid < 64) DEC[(size_t)g.slot_f * 64 + tid] = __expf(bF[63 * 64 + tid]);
          else if (tid < 128) DEC[(size_t)g.slot_b * 64 + tid - 64] = __expf(bB[tid - 64]); }
        __syncthreads();
#pragma unroll
        for (int dir = 0; dir < 2; ++dir) {
            const LAS bf16_t* ke = dir ? keB : keF; bf16_t* dst = UT + (size_t)(dir ? g.slot_b : g.slot_f) * 8192;
#pragma unroll
            for (int td = 0; td < 4; ++td) {
                f32x4 acc = (f32x4){0.f, 0.f, 0.f, 0.f};
                acc = mma_lds(vT + w * 16 * LDT, ke + td * 16 * LDT, LDT, LDT, 64, acc, fr, fq);
#pragma unroll
                for (int jj = 0; jj < 4; ++jj) dst[(w * 16 + fq * 4 + jj) * 64 + td * 16 + fr] = f2bf(acc[jj]);
            }
        }
        __syncthreads();
    }
}

__device__ __forceinline__ void g2_phase(const Params& p) {
    const bf16_t* UT = (const bf16_t*)(p.ws + WS_UT); bf16_t* ST = (bf16_t*)(p.ws + WS_ST); const float* DEC = (const float*)(p.ws + WS_DEC);
    for (int item = blockIdx.x * NTHREADS + opaque_tid(); item < 128 * 1024; item += gridDim.x * NTHREADS) {
        const int seq = item >> 10, e8 = item & 1023, e = e8 >> 3, d0 = (e8 & 7) * 8;
        const size_t slot0 = (size_t)seq * NCHS;
        float S[8];
#pragma unroll
        for (int i = 0; i < 8; ++i) S[i] = 0.f;
#pragma unroll 4
        for (int pp = 0; pp < NCHS; ++pp) {
            const u32x4 uu = *(const u32x4*)(UT + (slot0 + pp) * 8192 + e * 64 + d0);
            const f32x4 dc0 = *(const f32x4*)(DEC + (slot0 + pp) * 64 + d0), dc1 = *(const f32x4*)(DEC + (slot0 + pp) * 64 + d0 + 4);
            u32x4 o; o.x = cvt_pk_bf16(S[0], S[1]); o.y = cvt_pk_bf16(S[2], S[3]); o.z = cvt_pk_bf16(S[4], S[5]); o.w = cvt_pk_bf16(S[6], S[7]);
            *(u32x4*)(ST + (slot0 + pp) * 8192 + e * 64 + d0) = o;
            S[0] = dc0[0] * S[0] + bflo(uu.x); S[1] = dc0[1] * S[1] + bfhi(uu.x); S[2] = dc0[2] * S[2] + bflo(uu.y); S[3] = dc0[3] * S[3] + bfhi(uu.y);
            S[4] = dc1[0] * S[4] + bflo(uu.z); S[5] = dc1[1] * S[5] + bfhi(uu.z); S[6] = dc1[2] * S[6] + bflo(uu.w); S[7] = dc1[3] * S[7] + bfhi(uu.w);
        }
    }
}

__device__ __forceinline__ void g3_phase(const Params& p, int l, bool last, LAS unsigned char* lds) {
    const int tid = opaque_tid(), lane = tid & 63, w = tid >> 6, fr = lane & 15, fq = lane >> 4;
    const bf16_t* P = (const bf16_t*)(p.ws + WS_PROJ); const bf16_t* ST = (const bf16_t*)(p.ws + WS_ST);
    bf16_t* A = (bf16_t*)(p.ws + WS_A);
    LAS float* bF = (LAS float*)(lds + L_BF); LAS float* bB = (LAS float*)(lds + L_BB); LAS float* part = (LAS float*)(lds + L_PART);
    LAS bf16_t* qF = (LAS bf16_t*)(lds + L_QF); LAS bf16_t* kF = (LAS bf16_t*)(lds + L_KF); LAS bf16_t* qB = (LAS bf16_t*)(lds + L_QB); LAS bf16_t* kB = (LAS bf16_t*)(lds + L_KB);
    LAS bf16_t* pF = (LAS bf16_t*)(lds + L_PF); LAS bf16_t* pB = (LAS bf16_t*)(lds + L_PB); LAS bf16_t* vT = (LAS bf16_t*)(lds + L_VT);
    LAS bf16_t* sF = (LAS bf16_t*)(lds + L_SF); LAS bf16_t* sB = (LAS bf16_t*)(lds + L_SB);
    const int nunits = last ? 4096 : 4352;
    for (int u = blockIdx.x; u < nunits; u += gridDim.x) {
        const GUnit g = decode_unit(u);
        const int t = tid >> 3, d0 = (tid & 7) * 8;
        const u32x4 q8 = *(const u32x4*)(P + (size_t)(g.row0 + t) * NPROJ + 512 + g.h * 64 + d0);
        const u32x4 k8 = *(const u32x4*)(P + (size_t)(g.row0 + t) * NPROJ + 768 + g.h * 64 + d0);
        stage_vT(p, g, lds);
#pragma unroll
        for (int i = 0; i < 2; ++i) { const int c = tid + 512 * i, e = c >> 3, dc = (c & 7) * 8;
            *(LAS u32x4*)(sF + e * LDT + dc) = *(const u32x4*)(ST + (size_t)g.slot_f * 8192 + e * 64 + dc);
            *(LAS u32x4*)(sB + e * LDT + dc) = *(const u32x4*)(ST + (size_t)g.slot_b * 8192 + e * 64 + dc); }
        compute_decay(p, l, g, lds);
        { const float qf[8] = {bflo(q8.x), bfhi(q8.x), bflo(q8.y), bfhi(q8.y), bflo(q8.z), bfhi(q8.z), bflo(q8.w), bfhi(q8.w)};
          const float kf[8] = {bflo(k8.x), bfhi(k8.x), bflo(k8.y), bfhi(k8.y), bflo(k8.z), bfhi(k8.z), bflo(k8.w), bfhi(k8.w)};
          float a[8], b[8], c[8], dd2[8];
#pragma unroll
          for (int dd = 0; dd < 8; ++dd) { const float bf = bF[t * 64 + d0 + dd], bb = bB[t * 64 + d0 + dd];
              a[dd] = qf[dd] * 0.125f * __expf(bf); b[dd] = kf[dd] * __expf(-bf); c[dd] = qf[dd] * 0.125f * __expf(bb); dd2[dd] = kf[dd] * __expf(-bb); }
          u32x4 o;
          o.x = cvt_pk_bf16(a[0], a[1]); o.y = cvt_pk_bf16(a[2], a[3]); o.z = cvt_pk_bf16(a[4], a[5]); o.w = cvt_pk_bf16(a[6], a[7]); *(LAS u32x4*)(qF + t * LDT + d0) = o;
          o.x = cvt_pk_bf16(b[0], b[1]); o.y = cvt_pk_bf16(b[2], b[3]); o.z = cvt_pk_bf16(b[4], b[5]); o.w = cvt_pk_bf16(b[6], b[7]); *(LAS u32x4*)(kF + t * LDT + d0) = o;
          o.x = cvt_pk_bf16(c[0], c[1]); o.y = cvt_pk_bf16(c[2], c[3]); o.z = cvt_pk_bf16(c[4], c[5]); o.w = cvt_pk_bf16(c[6], c[7]); *(LAS u32x4*)(qB + t * LDT + d0) = o;
          o.x = cvt_pk_bf16(dd2[0], dd2[1]); o.y = cvt_pk_bf16(dd2[2], dd2[3]); o.z = cvt_pk_bf16(dd2[4], dd2[5]); o.w = cvt_pk_bf16(dd2[6], dd2[7]); *(LAS u32x4*)(kB + t * LDT + d0) = o; }
        __syncthreads();
        {
          const int dir = w >> 2, ti = w & 3;
          const LAS bf16_t* qq = dir ? qB : qF; const LAS bf16_t* kk = dir ? kB : kF; LAS bf16_t* pp = dir ? pB : pF;
#pragma unroll
          for (int tj = 0; tj < 4; ++tj) {
              f32x4 acc = (f32x4){0.f, 0.f, 0.f, 0.f};
              const bool live = dir ? (tj >= ti) : (tj <= ti);
              if (live) acc = mma_lds(qq + ti * 16 * LDT, kk + tj * 16 * LDT, LDT, LDT, 64, acc, fr, fq);
#pragma unroll
              for (int jj = 0; jj < 4; ++jj) { const int i = ti * 16 + fq * 4 + jj, j = tj * 16 + fr; const bool keep = dir ? (j >= i) : (j <= i);
                  pp[i * LDT + j] = f2bf(keep ? acc[jj] : 0.f); }
          } }
        __syncthreads();
        f32x4 oacc[4];
#pragma unroll
        for (int ti = 0; ti < 4; ++ti) oacc[ti] = (f32x4){0.f, 0.f, 0.f, 0.f};
#pragma unroll
        for (int dir = 0; dir < 2; ++dir) {
            const LAS bf16_t* qq = dir ? qB : qF; const LAS bf16_t* pp = dir ? pB : pF; const LAS bf16_t* ss = dir ? sB : sF;
#pragma unroll
            for (int ti = 0; ti < 4; ++ti) {
                oacc[ti] = mma_lds(pp + ti * 16 * LDT, vT + w * 16 * LDT, LDT, LDT, 64, oacc[ti], fr, fq);
                oacc[ti] = mma_lds(qq + ti * 16 * LDT, ss + w * 16 * LDT, LDT, LDT, 64, oacc[ti], fr, fq);
            }
        }
#pragma unroll
        for (int ti = 0; ti < 4; ++ti)
#pragma unroll
            for (int jj = 0; jj < 4; ++jj) { float ss = oacc[ti][jj] * oacc[ti][jj];
                ss += __shfl_xor(ss, 1); ss += __shfl_xor(ss, 2); ss += __shfl_xor(ss, 4); ss += __shfl_xor(ss, 8);
                if (fr == 0) part[(ti * 16 + fq * 4 + jj) * 8 + w] = ss; }
        __syncthreads();
        { const int e = w * 16 + fr; const float gn = p.gla_norm_g[l * 512 + g.h * 128 + e];
#pragma unroll
          for (int ti = 0; ti < 4; ++ti)
#pragma unroll
              for (int jj = 0; jj < 4; ++jj) { const int i = ti * 16 + fq * 4 + jj;
                  const f32x4 p0 = *(const LAS f32x4*)(part + i * 8), p1 = *(const LAS f32x4*)(part + i * 8 + 4);
                  const float tot = ((p0[0] + p0[1]) + (p0[2] + p0[3])) + ((p1[0] + p1[1]) + (p1[2] + p1[3]));
                  const float rstd = 1.0f / sqrtf(tot * (1.0f / 128.0f) + LN_EPS);
                  const float rr = bf2f(P[(size_t)(g.row0 + i) * NPROJ + 1536 + g.h * 128 + e]);
                  A[(size_t)(g.row0 + i) * D + 512 + g.h * 128 + e] = f2bf(oacc[ti][jj] * rstd * gn * silu_f(rr)); } }
        __syncthreads();
        { LAS float* uw = (LAS float*)(lds + L_UW); LAS bf16_t* pooled = (LAS bf16_t*)(lds + L_POOLED); LAS bf16_t* pwT = (LAS bf16_t*)(lds + L_PWT);
          const int tl0 = g.row0 - g.seq0;
          for (int c = tid; c < 80 * 16; c += NTHREADS) { const int rw = c >> 4, cc = (c & 15) * 8; const int pos = tl0 - 8 + rw;
              u32x4 v8 = (u32x4){0u, 0u, 0u, 0u};
              if (pos >= 0 && pos < g.seqlen) v8 = *(const u32x4*)(P + (size_t)(g.seq0 + pos) * NPROJ + g.h * 128 + cc);
              *(LAS f32x4*)(uw + rw * 128 + cc) = (f32x4){bflo(v8.x), bfhi(v8.x), bflo(v8.y), bfhi(v8.y)};
              *(LAS f32x4*)(uw + rw * 128 + cc + 4) = (f32x4){bflo(v8.z), bfhi(v8.z), bflo(v8.w), bfhi(v8.w)}; }
          const bf16_t* pwsrc = (const bf16_t*)(p.ws + WS_PW) + (size_t)(l * 4 + g.h) * 128 * 128;
#pragma unroll
          for (int i = 0; i < 4; ++i) { const int c = tid + 512 * i, dr = c >> 4, cc = (c & 15) * 8; *(LAS u32x4*)(pwT + dr * LDP + cc) = *(const u32x4*)(pwsrc + dr * 128 + cc); }
          __syncthreads();
          const int wn = 2 << g.h;
          { const int c = tid & 127;
            for (int i = 0; i < 16; ++i) { const int tt = (tid >> 7) + 4 * i; const int tl = tl0 + tt;
                int lo = tl - wn / 2; if (lo < 0) lo = 0; int hi = tl + (wn - 1 - wn / 2); if (hi > g.seqlen - 1) hi = g.seqlen - 1;
                float s = 0.f;
                for (int q = lo; q <= hi; ++q) s += uw[(q - tl0 + 8) * 128 + c];
                pooled[tt * LDP + c] = f2bf(s / (float)(hi - lo + 1) - uw[(tt + 8) * 128 + c]); } }
          __syncthreads();
          { const int dcol = w * 16 + fr; const float ps = p.pool_scale[l * 512 + g.h * 128 + dcol];
#pragma unroll
            for (int ti = 0; ti < 4; ++ti) { f32x4 acc = (f32x4){0.f, 0.f, 0.f, 0.f};
                acc = mma_lds(pooled + ti * 16 * LDP, pwT + w * 16 * LDP, LDP, LDP, 128, acc, fr, fq);
#pragma unroll
                for (int jj = 0; jj < 4; ++jj) A[(size_t)(g.row0 + ti * 16 + fq * 4 + jj) * D + g.h * 128 + dcol] = f2bf(acc[jj] * ps); } }
          __syncthreads(); }
    }
}

constexpr int NPHASE = 2 + 12 * DEPTH;
#ifndef NPH_RUN
#define NPH_RUN NPHASE
#endif
__global__ void __launch_bounds__(NTHREADS, 2) fwd_kernel(Params p) {
    extern __shared__ __attribute__((aligned(16))) unsigned char lds_raw[];
    LAS unsigned char* lds = (LAS unsigned char*)lds_raw;
    unsigned char* ws = p.ws;
    float* HC = (float*)(ws + WS_HC); bf16_t* A = (bf16_t*)(ws + WS_A); bf16_t* HID = (bf16_t*)(ws + WS_HID);
    const float* mod = (const float*)(ws + WS_MOD);
    if (p.ph_lo >= 100) {
        const int sel = p.ph_lo - 100; const size_t NO = (size_t)MLAT * D;
        const bf16_t* PJ = (const bf16_t*)(ws + WS_PROJ); const float* GDp = (const float*)(ws + WS_GD); const bf16_t* UT = (const bf16_t*)(ws + WS_UT); const bf16_t* ST = (const bf16_t*)(ws + WS_ST); const float* DEC = (const float*)(ws + WS_DEC);
        for (size_t i = (size_t)blockIdx.x * NTHREADS + threadIdx.x; i < NO; i += (size_t)gridDim.x * NTHREADS) {
            float v = 0.f;
            if (sel == 0) v = bf2f(PJ[i]) + bf2f(PJ[i + NO]);
            else if (sel == 1) v = GDp[i % ((size_t)MTOT * 32)];
            else if (sel == 2) v = bf2f(UT[i]) + (i < 4000000 ? bf2f(UT[i + NO]) : 0.f) + DEC[i % (SLOTS * 64)];
            else if (sel == 3) v = bf2f(ST[i]) + (i < 4000000 ? bf2f(ST[i + NO]) : 0.f);
            else if (sel == 5) v = DEC[i % (SLOTS * 64)];
            else if (sel == 6) v = bf2f(UT[i]) + (i < 4000000 ? bf2f(UT[i + NO]) : 0.f);
            else v = bf2f(A[i]) + (i < 4000000 ? bf2f(A[i + NO]) : 0.f);
            p.out[i] = v;
        }
        return;
    }
    for (int ph = p.ph_lo; ph < p.ph_hi; ++ph) {
        if (ph == 0) phase0a(p, lds);
        else if (ph == 1) ln_phase(p.x, p.ctx, p.out, HC, A, nullptr, nullptr, (const float*)(ws + WS_TAB), mod, 0, 1);
        else {
            const int l = (ph - 2) / 12, s = (ph - 2) % 12; const bool last = (l == DEPTH - 1);
            const float* modl = mod + (size_t)l * 17 * NMOD * D;
            if (s == 0 || s == 9) {
                pg8::Gemm g{A, (const bf16_t*)(ws + (s == 0 ? WS_WFA1 : WS_WFB1)) + (size_t)l * 2 * DFF * D, MTOT, 2 * DFF, D};
                pg8::StaticOrder S; S.init(MTOT, 2 * DFF, gridDim.x, blockIdx.x);
                EpiSwiglu E{HID}; pg8::gemm_phase<EpiSwiglu>(lds, g, S, E);
            } else if (s == 1 || s == 10) {
                pg8::Gemm g{HID, (const bf16_t*)(ws + (s == 1 ? WS_WFA2 : WS_WFB2)) + (size_t)l * D * DFF, MTOT, D, DFF};
                pg8::StaticOrder S; S.init(MTOT, D, gridDim.x, blockIdx.x);
                EpiResid E{p.out, HC, modl + (s == 1 ? 2 : 8) * D, 0.5f}; pg8::gemm_phase<EpiResid>(lds, g, S, E);
            } else if (s == 7) {
                pg8::Gemm g{A, (const bf16_t*)(ws + WS_WMO) + (size_t)l * D * D, MTOT, D, D};
                pg8::StaticOrder S; S.init(MTOT, D, gridDim.x, blockIdx.x);
                EpiResid E{p.out, HC, modl + 5 * D, 1.0f}; pg8::gemm_phase<EpiResid>(lds, g, S, E);
            } else if (s == 3) {
                pg8::Gemm g{A, (const bf16_t*)(ws + WS_WMI) + (size_t)l * NIN * D, MTOT, NIN, D};
                pg8::StaticOrder S; S.init(MTOT, NIN, gridDim.x, blockIdx.x);
                EpiMixIn E{(bf16_t*)(ws + WS_PROJ), (float*)(ws + WS_GD)}; pg8::gemm_phase<EpiMixIn>(lds, g, S, E);
            } else if (s == 2) ln_phase(p.out, HC, p.out, HC, A, p.ln_g + (l * 3 + 0) * D, p.ln_b + (l * 3 + 0) * D, nullptr, modl, 3, 4);
            else if (s == 8) ln_phase(p.out, HC, p.out, HC, A, p.ln_g + (l * 3 + 1) * D, p.ln_b + (l * 3 + 1) * D, nullptr, modl, 6, 7);
            else if (s == 11) ln_phase(p.out, HC, p.out, HC, A, p.ln_g + (l * 3 + 2) * D, p.ln_b + (l * 3 + 2) * D, nullptr, last ? nullptr : modl + (size_t)17 * NMOD * D, 0, 1);
            else if (s == 4) g1_phase(p, l, lds);
            else if (s == 5) g2_phase(p);
            else g3_phase(p, l, last, lds);
        }
        if (ph + 1 < p.ph_hi) cg::this_grid().sync();
    }
}

extern "C" void kernel_launch(void* const* d_in, const int* in_sizes, int n_in, void* d_out, int out_size, void* d_ws, size_t ws_size, hipStream_t stream) {
    static int grid = 0;
    if (grid == 0) {
        int dev = 0, cus = 0, per_cu = 0;
        hipGetDevice(&dev);
        hipDeviceGetAttribute(&cus, hipDeviceAttributeMultiprocessorCount, dev);
        if (hipFuncSetAttribute((const void*)fwd_kernel, hipFuncAttributeMaxDynamicSharedMemorySize, LDS_BYTES) != hipSuccess) fprintf(stderr, "kernel_launch: hipFuncSetAttribute failed\n");
        if (hipOccupancyMaxActiveBlocksPerMultiprocessor(&per_cu, (const void*)fwd_kernel, NTHREADS, LDS_BYTES) != hipSuccess || per_cu < 1) { fprintf(stderr, "kernel_launch: occupancy query says %d\n", per_cu); per_cu = 1; }
        (void)hipGetLastError();
        grid = cus * per_cu;
        if (ws_size < WS_END) fprintf(stderr, "kernel_launch: workspace too small (%zu < %zu)\n", ws_size, (size_t)WS_END);
    }
    Params p{};
    const float** fp = (const float**)&p;
    for (int i = 0; i < 21; ++i) fp[i] = (const float*)d_in[i];
    p.out = (float*)d_out; p.ws = (unsigned char*)d_ws;
#if ONE_LAUNCH
    p.ph_lo = 0; p.ph_hi = NPHASE;
    void* args[] = {&p};
    hipError_t e = hipLaunchCooperativeKernel((const void*)fwd_kernel, dim3(grid), dim3(NTHREADS), args, LDS_BYTES, stream);
    if (e != hipSuccess) fprintf(stderr, "cooperative launch failed: %s (grid %d)\n", hipGetErrorString(e), grid);
#else
    for (int ph = 0; ph < NPH_RUN; ++ph) {
        p.ph_lo = ph; p.ph_hi = ph + 1;
        hipLaunchKernelGGL(fwd_kernel, dim3(grid), dim3(NTHREADS), LDS_BYTES, stream, p);
    }
#ifdef DUMP_SEL
    p.ph_lo = 100 + DUMP_SEL; p.ph_hi = 0;
    hipLaunchKernelGGL(fwd_kernel, dim3(grid), dim3(NTHREADS), LDS_BYTES, stream, p);
#endif
#endif
}
```

```cpp
#include <hip/hip_runtime.h>
#include <hip/hip_cooperative_groups.h>
#include <cstdio>
namespace cg = cooperative_groups;

#ifndef ONE_LAUNCH
#define ONE_LAUNCH 1
#endif

#define LAS __attribute__((address_space(3)))
typedef unsigned short bf16_t;
typedef short bf16x8 __attribute__((ext_vector_type(8)));
typedef float f32x4 __attribute__((ext_vector_type(4)));
typedef float f32x2 __attribute__((ext_vector_type(2)));
typedef unsigned u32x4 __attribute__((ext_vector_type(4)));
typedef unsigned u32x2 __attribute__((ext_vector_type(2)));

constexpr int D = 1024, NBATCH = 16, SEQ = 4096, CTXL = 256, DEPTH = 4, DFF = 2816, NMOD = 9;
constexpr int MLAT = NBATCH * SEQ, MCTX = NBATCH * CTXL, MTOT = MLAT + MCTX;
constexpr int NIN_SRC = 2080, NIN = 2304, NPROJ = 2048;
constexpr int NCHS = 68;
constexpr float DN_ALPHA = 1.6817928305074292f;
constexpr float LN_EPS = 1e-6f;
constexpr int NTHREADS = 512;

constexpr size_t WS_CTL = 0;
constexpr size_t WS_HC = 65536;
constexpr size_t WS_A = WS_HC + (size_t)MCTX * D * 4;
constexpr size_t WS_HID = WS_A + (size_t)MTOT * D * 2;
constexpr size_t WS_PROJ = WS_HID;
constexpr size_t WS_GD = WS_HID + (size_t)MTOT * NPROJ * 2;
constexpr size_t WS_UT = WS_HID + (size_t)MTOT * DFF * 2;
constexpr size_t SLOTS = (size_t)2 * NBATCH * 4 * NCHS;
constexpr size_t WS_ST = WS_UT + SLOTS * 8192 * 2;
constexpr size_t WS_DEC = WS_ST + SLOTS * 8192 * 2;
constexpr size_t WS_MOD = WS_DEC + SLOTS * 64 * 4;
constexpr size_t WS_TAB = WS_MOD + (size_t)DEPTH * 17 * NMOD * D * 4;
constexpr size_t WS_PW = WS_TAB + 64 * 512 * 4;
constexpr size_t WS_WFA1 = WS_PW + (size_t)DEPTH * 4 * 128 * 128 * 2;
constexpr size_t WS_WFA2 = WS_WFA1 + (size_t)DEPTH * 2 * DFF * D * 2;
constexpr size_t WS_WMI = WS_WFA2 + (size_t)DEPTH * D * DFF * 2;
constexpr size_t WS_WMO = WS_WMI + (size_t)DEPTH * NIN * D * 2;
constexpr size_t WS_WFB1 = WS_WMO + (size_t)DEPTH * D * D * 2;
constexpr size_t WS_WFB2 = WS_WFB1 + (size_t)DEPTH * 2 * DFF * D * 2;
constexpr size_t WS_END = WS_WFB2 + (size_t)DEPTH * D * DFF * 2;
static_assert(WS_END <= (size_t)1073741824, "workspace too large");
static_assert((size_t)MTOT * NPROJ * 2 + (size_t)MTOT * 32 * 4 <= (size_t)MTOT * DFF * 2, "proj alias");

constexpr int LDS_MISC = 155648;
constexpr int LDS_BYTES = LDS_MISC + 16;

typedef __bf16 nbf16x2 __attribute__((ext_vector_type(2)));
__device__ __forceinline__ unsigned cvt_pk_bf16(float lo, float hi) { const f32x2 f = {lo, hi}; const nbf16x2 v = __builtin_convertvector(f, nbf16x2); return __builtin_bit_cast(unsigned, v); }
__device__ __forceinline__ float bf2f(unsigned short b) { return __uint_as_float(((unsigned)b) << 16); }
__device__ __forceinline__ float bflo(unsigned w) { return __uint_as_float(w << 16); }
__device__ __forceinline__ float bfhi(unsigned w) { return __uint_as_float(w & 0xffff0000u); }
__device__ __forceinline__ unsigned short f2bf(float f) { return __builtin_bit_cast(unsigned short, (__bf16)f); }
__device__ __forceinline__ float silu_f(float x) { return x / (1.0f + __expf(-x)); }
__device__ __forceinline__ int opaque_tid() { int t = threadIdx.x; asm volatile("" : "+v"(t)); return t; }
__device__ __forceinline__ float wave_sum(float v) {
#pragma unroll
    for (int o = 1; o < 64; o <<= 1) v += __shfl_xor(v, o);
    return v;
}

namespace pg8 {
constexpr int BM = 256, BK = 64, HALF = 128, HTB = HALF * BK * 2, STAGE_BYTES = 8 * HTB, NXCD = 8, WGM = 8;
__host__ __device__ __forceinline__ int lds_byte(int r, int c) { const int st = (r >> 4) * 2 + (c >> 5), rr = r & 15, cc = c & 31, ob = rr * 64 + cc * 2; return st * 1024 + (ob ^ (((ob >> 9) & 1) << 5)); }
__host__ __device__ __forceinline__ void stage_rc(int b, int& R, int& C) { const int st = b / 1024, sb = b % 1024, swz = sb ^ (((sb >> 9) & 1) << 5); R = (st >> 1) * 16 + swz / 64; C = (st & 1) * 32 + (swz % 64) / 2; }

struct Unit { int pm, pn; };
struct Gemm { const bf16_t* A; const bf16_t* Bt; int M, N, K; };

struct StaticOrder {
    int nM, nN, nwg, G, c;
    __device__ void init(int M, int N, int G_, int c_) { nM = M / BM; nN = N / BM; nwg = nM * nN; G = G_; c = c_; }
    __device__ bool next(int i, Unit& u) const {
        const long L = (long)i * G + c; if (L >= nwg) return false;
        int wgid = (int)L; { const int q = nwg / NXCD, r = nwg % NXCD, xcd = wgid % NXCD, off = wgid / NXCD; wgid = (xcd < r ? xcd * (q + 1) : r * (q + 1) + (xcd - r) * q) + off; }
        const int nig = WGM * nN, gid = wgid / nig, fm = gid * WGM, gsz = (nM - fm) < WGM ? (nM - fm) : WGM;
        u.pm = fm + ((wgid % nig) % gsz); u.pn = (wgid % nig) / gsz; return true;
    }
};

template <class Epi>
__device__ __forceinline__ void gemm_phase(LAS unsigned char* lds, const Gemm g, const StaticOrder& S, const Epi& E) {
    const int tid = opaque_tid(), wid = __builtin_amdgcn_readfirstlane(tid >> 6), lane = tid & 63, wr = wid >> 2, wc = wid & 3, fr = lane & 15, fq = lane >> 4;
    const int K = g.K, nt = K / BK;
    unsigned voffA[2];
#pragma unroll
    for (int i = 0; i < 2; ++i) { int R, C; stage_rc(tid * 16 + i * 8192, R, C); voffA[i] = (unsigned)(R * K + C) * 2u; }
    const size_t kstep = (size_t)(BK * 2);
    const size_t hstep = (size_t)HALF * K * 2;
    const size_t tstep = 2 * hstep;
    const unsigned ldsw = (unsigned)wid * 1024u;
    const int aoff = lds_byte(wr * 64 + fr, fq * 8), boff = lds_byte(wc * 32 + fr, fq * 8);
#define PG8_SA(b, h) (((b) * 2 + (h)) * HTB)
#define PG8_SB(b, h) ((4 + (b) * 2 + (h)) * HTB)
#define PG8_STAGE(bufoff, gbase) do { _Pragma("unroll") for (int _i = 0; _i < 2; ++_i) \
        __builtin_amdgcn_global_load_lds((const unsigned*)((const char*)(gbase) + voffA[_i]), (LAS unsigned*)(lds + (bufoff) + ldsw + _i * 8192), 16, 0, 0); } while (0)
#define PG8_LDA(dst, b, h) do { _Pragma("unroll") for (int m = 0; m < 4; ++m) _Pragma("unroll") for (int k = 0; k < 2; ++k) dst[m][k] = *(const LAS bf16x8*)(lds + PG8_SA(b, h) + aoff + m * 2048 + k * 1024); } while (0)
#define PG8_LDB(dst, b, h) do { _Pragma("unroll") for (int n = 0; n < 2; ++n) _Pragma("unroll") for (int k = 0; k < 2; ++k) dst[n][k] = *(const LAS bf16x8*)(lds + PG8_SB(b, h) + boff + n * 2048 + k * 1024); } while (0)
#define PG8_MMA(ai, bj, At, Bt) do { __builtin_amdgcn_s_setprio(1); _Pragma("unroll") for (int m = 0; m < 4; ++m) _Pragma("unroll") for (int n = 0; n < 2; ++n) _Pragma("unroll") for (int k = 0; k < 2; ++k) \
        acc[ai][bj][m][n] = __builtin_amdgcn_mfma_f32_16x16x32_bf16(Bt[n][k], At[m][k], acc[ai][bj][m][n], 0, 0, 0); __builtin_amdgcn_s_setprio(0); } while (0)
#define PG8_WAIT_V(n) asm volatile("s_waitcnt vmcnt(" #n ")" ::: "memory")
#define PG8_WAIT_L(n) asm volatile("s_waitcnt lgkmcnt(" #n ")" ::: "memory")
#define PG8_BAR __builtin_amdgcn_s_barrier()
#define PG8_SCHED __builtin_amdgcn_sched_barrier(0)
    Unit cur, nxt; int ui = 0;
    if (!S.next(0, cur)) return;
    f32x4 acc[2][2][4][2];
#pragma unroll
    for (int a = 0; a < 2; ++a)
#pragma unroll
        for (int b = 0; b < 2; ++b)
#pragma unroll
            for (int m = 0; m < 4; ++m)
#pragma unroll
                for (int n = 0; n < 2; ++n) acc[a][b][m][n] = (f32x4){0.f, 0.f, 0.f, 0.f};
    bf16x8 At[4][2], B0[2][2], B1[2][2];
    const char* cA = (const char*)g.A + (size_t)cur.pm * tstep; const char* cB = (const char*)g.Bt + (size_t)cur.pn * tstep;
    PG8_STAGE(PG8_SB(0, 0), cB); PG8_STAGE(PG8_SA(0, 0), cA); PG8_STAGE(PG8_SB(0, 1), cB + hstep); PG8_STAGE(PG8_SA(0, 1), cA + hstep);
    if (wr == 1) PG8_BAR;
    PG8_WAIT_V(4); PG8_BAR;
    PG8_STAGE(PG8_SB(1, 0), cB + kstep); PG8_STAGE(PG8_SA(1, 0), cA + kstep); PG8_STAGE(PG8_SB(1, 1), cB + hstep + kstep);
    PG8_WAIT_V(6); PG8_BAR;
    for (;;) {
        const bool has_next = S.next(ui + 1, nxt);
        const char* nA = has_next ? (const char*)g.A + (size_t)nxt.pm * tstep : cA; const char* nB = has_next ? (const char*)g.Bt + (size_t)nxt.pn * tstep : cB;
        for (int t = 0; t < nt; t += 2) {
            const bool last = (t == nt - 2);
            const char* a1 = cA + (size_t)(t + 1) * kstep;
            const char* a2 = last ? nA : cA + (size_t)(t + 2) * kstep; const char* b2 = last ? nB : cB + (size_t)(t + 2) * kstep;
            const char* a3 = a2 + kstep; const char* b3 = b2 + kstep;
            PG8_LDB(B0, 0, 0); PG8_SCHED; PG8_LDA(At, 0, 0); PG8_STAGE(PG8_SA(1, 1), a1 + hstep);
            PG8_WAIT_L(8); PG8_BAR; PG8_WAIT_L(0); PG8_MMA(0, 0, At, B0); PG8_BAR; PG8_SCHED;
            PG8_LDB(B1, 0, 1); PG8_STAGE(PG8_SB(0, 0), b2);
            PG8_BAR; PG8_WAIT_L(0); PG8_MMA(0, 1, At, B1); PG8_BAR;
            PG8_LDA(At, 0, 1); PG8_STAGE(PG8_SA(0, 0), a2);
            PG8_BAR; PG8_WAIT_L(0); PG8_MMA(1, 0, At, B0); PG8_BAR; PG8_SCHED;
            PG8_STAGE(PG8_SB(0, 1), b2 + hstep);
            PG8_WAIT_V(6); PG8_BAR; PG8_MMA(1, 1, At, B1); PG8_BAR;
            PG8_LDB(B0, 1, 0); PG8_SCHED; PG8_LDA(At, 1, 0); PG8_STAGE(PG8_SA(0, 1), a2 + hstep);
            PG8_WAIT_L(8); PG8_BAR; PG8_WAIT_L(0); PG8_MMA(0, 0, At, B0); PG8_BAR; PG8_SCHED;
            PG8_LDB(B1, 1, 1); PG8_STAGE(PG8_SB(1, 0), b3);
            PG8_BAR; PG8_WAIT_L(0); PG8_MMA(0, 1, At, B1); PG8_BAR;
            PG8_LDA(At, 1, 1); PG8_STAGE(PG8_SA(1, 0), a3);
            PG8_BAR; PG8_WAIT_L(0); PG8_MMA(1, 0, At, B0); PG8_BAR; PG8_SCHED;
            PG8_STAGE(PG8_SB(1, 1), b3 + hstep);
            PG8_WAIT_V(6); PG8_BAR; PG8_MMA(1, 1, At, B1); PG8_BAR;
        }
        E(acc, cur, wr, wc, fr, fq);
        if (!has_next) break;
#pragma unroll
        for (int a = 0; a < 2; ++a)
#pragma unroll
            for (int b = 0; b < 2; ++b)
#pragma unroll
                for (int m = 0; m < 4; ++m)
#pragma unroll
                    for (int n = 0; n < 2; ++n) acc[a][b][m][n] = (f32x4){0.f, 0.f, 0.f, 0.f};
        cur = nxt; cA = nA; cB = nB; ++ui;
    }
    PG8_WAIT_V(0);
    if (wr == 0) PG8_BAR;
    PG8_BAR;
#undef PG8_SA
#undef PG8_SB
#undef PG8_STAGE
#undef PG8_LDA
#undef PG8_LDB
#undef PG8_MMA
#undef PG8_WAIT_V
#undef PG8_WAIT_L
#undef PG8_BAR
#undef PG8_SCHED
}
}

struct EpiSwiglu {
    bf16_t* H;
    __device__ __forceinline__ void operator()(const f32x4 (&acc)[2][2][4][2], const pg8::Unit& u, int wr, int wc, int fr, int fq) const {
        const int row0 = u.pm * 256 + wr * 64 + fr, hc0 = u.pn * 128 + wc * 16 + 4 * fq;
#pragma unroll
        for (int ai = 0; ai < 2; ++ai)
#pragma unroll
            for (int m = 0; m < 4; ++m) { bf16_t* rowp = H + (size_t)(row0 + ai * 128 + m * 16) * DFF + hc0;
#pragma unroll
                for (int bj = 0; bj < 2; ++bj) { const f32x4 gg = acc[ai][bj][m][0], uu = acc[ai][bj][m][1];
                    u32x2 w; w.x = cvt_pk_bf16(silu_f(gg[0]) * uu[0], silu_f(gg[1]) * uu[1]); w.y = cvt_pk_bf16(silu_f(gg[2]) * uu[2], silu_f(gg[3]) * uu[3]);
                    *(u32x2*)(rowp + bj * 64) = w; } }
    }
};
struct EpiResid {
    float* lat; float* ctx; const float* gate; float gs;
    __device__ __forceinline__ void operator()(const f32x4 (&acc)[2][2][4][2], const pg8::Unit& u, int wr, int wc, int fr, int fq) const {
        const int row0 = u.pm * 256 + wr * 64 + fr, col0 = u.pn * 256 + wc * 32 + 4 * fq;
        const int grp = (u.pm < 256) ? (u.pm >> 4) : 16;
        f32x4 gv[2][2];
#pragma unroll
        for (int bj = 0; bj < 2; ++bj)
#pragma unroll
            for (int n = 0; n < 2; ++n) gv[bj][n] = *(const f32x4*)(gate + (size_t)grp * (NMOD * D) + col0 + bj * 128 + n * 16) * gs;
#pragma unroll
        for (int ai = 0; ai < 2; ++ai)
#pragma unroll
            for (int m = 0; m < 4; ++m) { const int r = row0 + ai * 128 + m * 16;
                float* rowp = (r < MLAT ? lat + (size_t)r * D : ctx + (size_t)(r - MLAT) * D) + col0;
#pragma unroll
                for (int bj = 0; bj < 2; ++bj)
#pragma unroll
                    for (int n = 0; n < 2; ++n) { const f32x4 h = *(const f32x4*)(rowp + bj * 128 + n * 16); *(f32x4*)(rowp + bj * 128 + n * 16) = h * DN_ALPHA + gv[bj][n] * acc[ai][bj][m][n]; }
                asm volatile("" ::: "memory"); }
    }
};
struct EpiMixIn {
    bf16_t* P; float* GDp;
    __device__ __forceinline__ void operator()(const f32x4 (&acc)[2][2][4][2], const pg8::Unit& u, int wr, int wc, int fr, int fq) const {
        const int row0 = u.pm * 256 + wr * 64 + fr;
        if (u.pn < 8) {
            const int col0 = u.pn * 256 + wc * 32 + 4 * fq;
#pragma unroll
            for (int ai = 0; ai < 2; ++ai)
#pragma unroll
                for (int m = 0; m < 4; ++m) { bf16_t* rowp = P + (size_t)(row0 + ai * 128 + m * 16) * NPROJ + col0;
#pragma unroll
                    for (int bj = 0; bj < 2; ++bj)
#pragma unroll
                        for (int n = 0; n < 2; ++n) { const f32x4 v = acc[ai][bj][m][n]; u32x2 w; w.x = cvt_pk_bf16(v[0], v[1]); w.y = cvt_pk_bf16(v[2], v[3]); *(u32x2*)(rowp + bj * 128 + n * 16) = w; } }
        } else if (wc == 0) {
#pragma unroll
            for (int ai = 0; ai < 2; ++ai)
#pragma unroll
                for (int m = 0; m < 4; ++m) { float* rowp = GDp + (size_t)(row0 + ai * 128 + m * 16) * 32 + 4 * fq;
#pragma unroll
                    for (int n = 0; n < 2; ++n) *(f32x4*)(rowp + n * 16) = acc[ai][0][m][n]; }
        }
    }
};

struct Params {
    const float *x, *c, *ctx, *c_ctx, *w_ada, *b_ada, *ln_g, *ln_b, *ffa_w_in, *ffa_w_out, *mix_w_in, *pool_w, *pool_scale,
                *gate_up_f, *gate_bias_f, *gate_up_b, *gate_bias_b, *gla_norm_g, *mix_w_out, *ffb_w_in, *ffb_w_out;
    float* out; unsigned char* ws;
    int ph_lo, ph_hi;
};

__device__ __forceinline__ int srccol(int mode, int R, int Nsrc) {
    if (mode == 0) return R;
    if (mode == 1) { const int pn = R >> 8, cc = R & 255, grp = cc >> 5, isu = (cc >> 4) & 1, w = cc & 15; return isu * DFF + pn * 128 + grp * 16 + w; }
    return R < Nsrc ? R : -1;
}
__device__ __forceinline__ void transpose_tile(const float* W, int K, int Nsrc, bf16_t* Wt, int mode, int kb, int rb, LAS float* scr) {
    const int tid = opaque_tid(), nn = tid & 63, k0 = kb * 64, R0 = rb * 64;
    const int sc = srccol(mode, R0 + nn, Nsrc);
#pragma unroll
    for (int i = 0; i < 8; ++i) { const int kk = (tid >> 6) + 8 * i; scr[kk * 65 + nn] = sc >= 0 ? W[(size_t)(k0 + kk) * Nsrc + sc] : 0.f; }
    __syncthreads();
    { const int n = tid >> 3, c8 = tid & 7; const LAS float* s = scr + (8 * c8) * 65 + n;
      u32x4 o; o.x = cvt_pk_bf16(s[0], s[65]); o.y = cvt_pk_bf16(s[2 * 65], s[3 * 65]); o.z = cvt_pk_bf16(s[4 * 65], s[5 * 65]); o.w = cvt_pk_bf16(s[6 * 65], s[7 * 65]);
      *(u32x4*)(Wt + (size_t)(R0 + n) * K + k0 + 8 * c8) = o; }
    __syncthreads();
}
__device__ __forceinline__ void convert_weight(const float* W, int K, int Nsrc, int Ndst, bf16_t* Wt, int mode, LAS float* scr, int& base) {
    const int G = gridDim.x, nrb = Ndst / 64, cnt = (K / 64) * nrb;
    const int first = (int)(((long)blockIdx.x + (long)G * 1024 - base) % G);
    for (int it = first; it < cnt; it += G) transpose_tile(W, K, Nsrc, Wt, mode, it / nrb, it % nrb, scr);
    base = (base + cnt) % G;
}

__device__ __forceinline__ void phase0a(const Params& p, LAS unsigned char* lds) {
    const int tid = opaque_tid(), lane = tid & 63, w = tid >> 6, G = gridDim.x;
    unsigned char* ws = p.ws;
    {
        LAS float* sc = (LAS float*)lds;
        LAS float* part = (LAS float*)(lds + 69632);
        float* mod = (float*)(ws + WS_MOD);
        if ((int)blockIdx.x < DEPTH * 144) {
            for (int idx = tid; idx < 17 * 1024; idx += NTHREADS) { const int g = idx >> 10, i = idx & 1023; const float v = g < 16 ? p.c[g * 1024 + i] : p.c_ctx[i]; sc[idx] = silu_f(v); }
            __syncthreads();
            for (int unit = blockIdx.x; unit < DEPTH * 144; unit += G) {
                const int l = unit / 144, jb = unit % 144;
                float acc[17];
#pragma unroll
                for (int g = 0; g < 17; ++g) acc[g] = 0.f;
                const float* wp = p.w_ada + ((size_t)l * 1024 + w * 128) * (NMOD * D) + jb * 64 + lane;
#pragma unroll 4
                for (int i = 0; i < 128; ++i) { const float wv = wp[(size_t)i * (NMOD * D)];
#pragma unroll
                    for (int g = 0; g < 17; ++g) acc[g] += sc[g * 1024 + w * 128 + i] * wv; }
#pragma unroll
                for (int g = 0; g < 17; ++g) part[(w * 17 + g) * 64 + lane] = acc[g];
                __syncthreads();
                for (int idx = tid; idx < 17 * 64; idx += NTHREADS) { const int g = idx >> 6, jj = idx & 63; float s = 0.f;
#pragma unroll
                    for (int ww = 0; ww < 8; ++ww) s += part[(ww * 17 + g) * 64 + jj];
                    mod[((size_t)l * 17 + g) * (NMOD * D) + jb * 64 + jj] = s + p.b_ada[l * (NMOD * D) + jb * 64 + jj]; }
                __syncthreads();
            }
        }
    }
    {
        float* tab = (float*)(ws + WS_TAB);
        for (int idx = blockIdx.x * NTHREADS + tid; idx < 64 * 256; idx += G * NTHREADS) {
            const int pp = idx >> 8, i = idx & 255;
            const float omega = 1.0f / expf(9.210340371976184f * ((float)i / 256.0f));
            const float a = (float)pp * omega;
            const double ad = (double)a; const double kq = rint(ad * 0.6366197723675814);
            double r = fma(-kq, 1.5707963267948966, ad); r = fma(-kq, 6.123233995736766e-17, r);
            const int q = ((int)kq) & 3; const double r2 = r * r;
            const double sr = r * (1.0 + r2 * (-1.0 / 6 + r2 * (1.0 / 120 + r2 * (-1.0 / 5040 + r2 * (1.0 / 362880 + r2 * (-1.0 / 39916800 + r2 * (1.0 / 6227020800.0)))))));
            const double cr = 1.0 + r2 * (-0.5 + r2 * (1.0 / 24 + r2 * (-1.0 / 720 + r2 * (1.0 / 40320 + r2 * (-1.0 / 3628800 + r2 * (1.0 / 479001600 + r2 * (-1.0 / 87178291200.0)))))));
            double s, c;
            if (q == 0) { s = sr; c = cr; } else if (q == 1) { s = cr; c = -sr; } else if (q == 2) { s = -sr; c = -cr; } else { s = -cr; c = sr; }
            tab[pp * 512 + i] = (float)s; tab[pp * 512 + 256 + i] = (float)c;
        }
    }
    {
        LAS float* scr = (LAS float*)lds;
        int base = 0;
        for (int l = 0; l < DEPTH; ++l) {
            convert_weight(p.ffa_w_in + (size_t)l * D * 2 * DFF, D, 2 * DFF, 2 * DFF, (bf16_t*)(ws + WS_WFA1) + (size_t)l * 2 * DFF * D, 1, scr, base);
            convert_weight(p.ffb_w_in + (size_t)l * D * 2 * DFF, D, 2 * DFF, 2 * DFF, (bf16_t*)(ws + WS_WFB1) + (size_t)l * 2 * DFF * D, 1, scr, base);
            convert_weight(p.ffa_w_out + (size_t)l * DFF * D, DFF, D, D, (bf16_t*)(ws + WS_WFA2) + (size_t)l * D * DFF, 0, scr, base);
            convert_weight(p.ffb_w_out + (size_t)l * DFF * D, DFF, D, D, (bf16_t*)(ws + WS_WFB2) + (size_t)l * D * DFF, 0, scr, base);
            convert_weight(p.mix_w_in + (size_t)l * D * NIN_SRC, D, NIN_SRC, NIN, (bf16_t*)(ws + WS_WMI) + (size_t)l * NIN * D, 2, scr, base);
            convert_weight(p.mix_w_out + (size_t)l * D * D, D, D, D, (bf16_t*)(ws + WS_WMO) + (size_t)l * D * D, 0, scr, base);
            for (int g = 0; g < 4; ++g)
                convert_weight(p.pool_w + (size_t)(l * 4 + g) * 128 * 128, 128, 128, 128, (bf16_t*)(ws + WS_PW) + (size_t)(l * 4 + g) * 128 * 128, 0, scr, base);
        }
    }
}

__device__ __forceinline__ void ln_phase(const float* src_lat, const float* src_ctx, float* dst_lat, float* dst_ctx, bf16_t* A,
                                         const float* gam, const float* bet, const float* tab, const float* modl, int ish, int isc) {
    const int tid = opaque_tid(), lane = tid & 63, w = tid >> 6;
    const int gw = blockIdx.x * 8 + w, NGW = gridDim.x * 8;
    for (int blk = gw; blk < MTOT / 16; blk += NGW) {
        const int r0 = blk * 16;
        const int grp = r0 < MLAT ? (r0 >> 12) : 16;
        f32x4 gv[4], bv[4], shv[4], scv[4];
#pragma unroll
        for (int j = 0; j < 4; ++j) { const int col = 4 * lane + 256 * j;
            gv[j] = gam ? *(const f32x4*)(gam + col) : (f32x4){1.f, 1.f, 1.f, 1.f};
            bv[j] = bet ? *(const f32x4*)(bet + col) : (f32x4){0.f, 0.f, 0.f, 0.f};
            if (modl) { shv[j] = *(const f32x4*)(modl + (size_t)grp * (NMOD * D) + ish * D + col); scv[j] = *(const f32x4*)(modl + (size_t)grp * (NMOD * D) + isc * D + col) + 1.0f; }
            else { shv[j] = (f32x4){0.f, 0.f, 0.f, 0.f}; scv[j] = (f32x4){1.f, 1.f, 1.f, 1.f}; } }
        for (int rr = 0; rr < 16; rr += 4) {
            f32x4 v[4][4];
#pragma unroll
            for (int q = 0; q < 4; ++q) { const int r = r0 + rr + q;
                const float* sp = r < MLAT ? src_lat + (size_t)r * D : src_ctx + (size_t)(r - MLAT) * D;
#pragma unroll
                for (int j = 0; j < 4; ++j) v[q][j] = *(const f32x4*)(sp + 4 * lane + 256 * j); }
#pragma unroll
            for (int q = 0; q < 4; ++q) { const int r = r0 + rr + q;
                float* dp = r < MLAT ? dst_lat + (size_t)r * D : dst_ctx + (size_t)(r - MLAT) * D;
                float s = 0.f;
                if (tab && r < MLAT) { const int t = r & (SEQ - 1), prow = t >> 6, pcol = t & 63;
#pragma unroll
                    for (int j = 0; j < 4; ++j) { const int col = 4 * lane + 256 * j; v[q][j] += (j < 2) ? *(const f32x4*)(tab + prow * 512 + col) : *(const f32x4*)(tab + pcol * 512 + col - 512); } }
#pragma unroll
                for (int j = 0; j < 4; ++j) s += (v[q][j][0] + v[q][j][1]) + (v[q][j][2] + v[q][j][3]);
                const float mean = wave_sum(s) * (1.0f / D); float s2 = 0.f;
#pragma unroll
                for (int j = 0; j < 4; ++j) { v[q][j] = v[q][j] - mean; s2 += (v[q][j][0] * v[q][j][0] + v[q][j][1] * v[q][j][1]) + (v[q][j][2] * v[q][j][2] + v[q][j][3] * v[q][j][3]); }
                const float rstd = 1.0f / sqrtf(wave_sum(s2) * (1.0f / D) + LN_EPS);
#pragma unroll
                for (int j = 0; j < 4; ++j) { const f32x4 h = v[q][j] * rstd * gv[j] + bv[j]; *(f32x4*)(dp + 4 * lane + 256 * j) = h;
                    if (modl) { const f32x4 a = h * scv[j] + shv[j]; u32x2 o; o.x = cvt_pk_bf16(a[0], a[1]); o.y = cvt_pk_bf16(a[2], a[3]); *(u32x2*)(A + (size_t)r * D + 4 * lane + 256 * j) = o; } }
            }
        }
    }
}

constexpr int L_BF = 0, L_BB = 16384, L_GD = 32768, L_TOT = 40960, L_PART = 43008, L_QF = 45056, L_KF = 54272, L_QB = 63488, L_KB = 72704,
              L_PF = 81920, L_PB = 91136, L_VT = 100352, L_SF = 118784, L_SB = 137216;
constexpr int L_GU = L_PF, L_BIAS = L_PB;
constexpr int L_UW = 0, L_POOLED = L_QF, L_PWT = L_QB;
constexpr int LDT = 72, LDP = 136;
static_assert(L_SB + 128 * LDT * 2 <= LDS_MISC, "lds");

__device__ __forceinline__ f32x4 mma_lds(const LAS bf16_t* A, const LAS bf16_t* B, int lda, int ldb, int K, f32x4 acc, int fr, int fq) {
    for (int k0 = 0; k0 < K; k0 += 32) {
        const bf16x8 a = *(const LAS bf16x8*)(A + fr * lda + k0 + fq * 8);
        const bf16x8 b = *(const LAS bf16x8*)(B + fr * ldb + k0 + fq * 8);
        acc = __builtin_amdgcn_mfma_f32_16x16x32_bf16(a, b, acc, 0, 0, 0);
    }
    return acc;
}

struct GUnit { int b, n, isctx, h, row0, slot_f, slot_b, seq0, seqlen; };
__device__ __forceinline__ GUnit decode_unit(int u) {
    GUnit g; g.h = u & 3; const int cn = u >> 2;
    if (cn < 1024) { g.b = cn >> 6; g.n = cn & 63; g.isctx = 0; g.row0 = g.b * SEQ + g.n * 64; g.seq0 = g.b * SEQ; g.seqlen = SEQ;
        g.slot_f = ((0 * 16 + g.b) * 4 + g.h) * NCHS + 4 + g.n; g.slot_b = ((16 + g.b) * 4 + g.h) * NCHS + 4 + (63 - g.n); }
    else { const int c2 = cn - 1024; g.b = c2 >> 2; g.n = c2 & 3; g.isctx = 1; g.row0 = MLAT + g.b * CTXL + g.n * 64; g.seq0 = MLAT + g.b * CTXL; g.seqlen = CTXL;
        g.slot_f = ((0 * 16 + g.b) * 4 + g.h) * NCHS + g.n; g.slot_b = ((16 + g.b) * 4 + g.h) * NCHS + (3 - g.n); }
    return g;
}

__device__ __forceinline__ void compute_decay(const Params& p, int l, const GUnit& g, LAS unsigned char* lds) {
    const int tid = opaque_tid();
    const float* GDp = (const float*)(p.ws + WS_GD);
    LAS float* bF = (LAS float*)(lds + L_BF); LAS float* bB = (LAS float*)(lds + L_BB); LAS float* gd = (LAS float*)(lds + L_GD);
    LAS float* tot = (LAS float*)(lds + L_TOT); LAS float* gu = (LAS float*)(lds + L_GU); LAS float* bias = (LAS float*)(lds + L_BIAS);
    { const int row = tid >> 3, c4 = (tid & 7) * 4; *(LAS f32x4*)(gd + row * 32 + c4) = *(const f32x4*)(GDp + (size_t)(g.row0 + row) * 32 + c4); }
    {
      const int dir = tid >> 8, r = (tid >> 4) & 15, c4 = (tid & 15) * 4;
      const float* src = (dir ? p.gate_up_b : p.gate_up_f) + (size_t)l * 16 * 256 + r * 256 + g.h * 64 + c4;
      *(LAS f32x4*)(gu + dir * 1024 + r * 64 + c4) = *(const f32x4*)src;
      if (tid < 128) { const int dr = tid >> 6, dd = tid & 63; bias[tid] = (dr ? p.gate_bias_b : p.gate_bias_f)[l * 256 + g.h * 64 + dd]; } }
    __syncthreads();
    { const int t = tid >> 3, d0 = (tid & 7) * 8;
#pragma unroll
      for (int dir = 0; dir < 2; ++dir) {
          float z[8];
#pragma unroll
          for (int dd = 0; dd < 8; ++dd) z[dd] = bias[dir * 64 + d0 + dd];
#pragma unroll
          for (int r = 0; r < 16; ++r) { const float gv = gd[t * 32 + dir * 16 + r];
#pragma unroll
              for (int dd = 0; dd < 8; ++dd) z[dd] += gv * gu[dir * 1024 + r * 64 + d0 + dd]; }
          LAS float* dst = (dir ? bB : bF) + t * 64 + d0;
#pragma unroll
          for (int dd = 0; dd < 8; ++dd) { const float zz = z[dd]; const float ls = fminf(zz, 0.f) - __logf(1.0f + __expf(-fabsf(zz))); dst[dd] = ls * (1.0f / 16.0f); }
      } }
    __syncthreads();
    const int c = tid & 127, dir = c >> 6, d = c & 63, seg = tid >> 7;
    LAS float* col = (dir ? bB : bF) + d;
    const int tb = dir ? (63 - seg * 16) : seg * 16, ts = dir ? -64 : 64;
    float x[16];
#pragma unroll
    for (int i = 0; i < 16; ++i) x[i] = col[tb * 64 + i * ts];
#pragma unroll
    for (int i = 1; i < 16; ++i) x[i] += x[i - 1];
    tot[seg * 128 + c] = x[15];
    __syncthreads();
    { float off = 0.f;
      for (int s = 0; s < seg; ++s) off += tot[s * 128 + c];
#pragma unroll
      for (int i = 0; i < 16; ++i) col[tb * 64 + i * ts] = x[i] + off; }
    __syncthreads();
}
__device__ __forceinline__ void stage_vT(const Params& p, const GUnit& g, LAS unsigned char* lds) {
    const int tid = opaque_tid(), lane = tid & 63, w = tid >> 6;
    const bf16_t* P = (const bf16_t*)(p.ws + WS_PROJ);
    LAS bf16_t* vT = (LAS bf16_t*)(lds + L_VT);
#pragma unroll
    for (int i = 0; i < 2; ++i) { const int e0 = 8 * (w + 8 * i);
        const u32x4 v8 = *(const u32x4*)(P + (size_t)(g.row0 + lane) * NPROJ + 1024 + g.h * 128 + e0);
        vT[(e0 + 0) * LDT + lane] = (bf16_t)(v8.x & 0xffff); vT[(e0 + 1) * LDT + lane] = (bf16_t)(v8.x >> 16);
        vT[(e0 + 2) * LDT + lane] = (bf16_t)(v8.y & 0xffff); vT[(e0 + 3) * LDT + lane] = (bf16_t)(v8.y >> 16);
        vT[(e0 + 4) * LDT + lane] = (bf16_t)(v8.z & 0xffff); vT[(e0 + 5) * LDT + lane] = (bf16_t)(v8.z >> 16);
        vT[(e0 + 6) * LDT + lane] = (bf16_t)(v8.w & 0xffff); vT[(e0 + 7) * LDT + lane] = (bf16_t)(v8.w >> 16); }
}

__device__ __forceinline__ void g1_phase(const Params& p, int l, LAS unsigned char* lds) {
    const int tid = opaque_tid(), lane = tid & 63, w = tid >> 6, fr = lane & 15, fq = lane >> 4;
    const bf16_t* P = (const bf16_t*)(p.ws + WS_PROJ);
    bf16_t* UT = (bf16_t*)(p.ws + WS_UT); float* DEC = (float*)(p.ws + WS_DEC);
    LAS float* bF = (LAS float*)(lds + L_BF); LAS float* bB = (LAS float*)(lds + L_BB);
    LAS bf16_t* keF = (LAS bf16_t*)(lds + L_KF); LAS bf16_t* keB = (LAS bf16_t*)(lds + L_KB); LAS bf16_t* vT = (LAS bf16_t*)(lds + L_VT);
    for (int u = blockIdx.x; u < 4352; u += gridDim.x) {
        const GUnit g = decode_unit(u);
        const int t = tid >> 3, d0 = (tid & 7) * 8;
        const u32x4 k8 = *(const u32x4*)(P + (size_t)(g.row0 + t) * NPROJ + 768 + g.h * 64 + d0);
        stage_vT(p, g, lds);
        compute_decay(p, l, g, lds);
        { float kf[8] = {bflo(k8.x), bfhi(k8.x), bflo(k8.y), bfhi(k8.y), bflo(k8.z), bfhi(k8.z), bflo(k8.w), bfhi(k8.w)};
#pragma unroll
          for (int dd = 0; dd < 8; ++dd) { const int d = d0 + dd;
              keF[d * LDT + t] = f2bf(kf[dd] * __expf(bF[63 * 64 + d] - bF[t * 64 + d]));
              keB[d * LDT + t] = f2bf(kf[dd] * __expf(bB[d] - bB[t * 64 + d])); }
          if (tid < 64) DEC[(size_t)g.slot_f * 64 + tid] = __expf(bF[63 * 64 + tid]);
          else if (tid < 128) DEC[(size_t)g.slot_b * 64 + tid - 64] = __expf(bB[tid - 64]); }
        __syncthreads();
#pragma unroll
        for (int dir = 0; dir < 2; ++dir) {
            const LAS bf16_t* ke = dir ? keB : keF; bf16_t* dst = UT + (size_t)(dir ? g.slot_b : g.slot_f) * 8192;
#pragma unroll
            for (int td = 0; td < 4; ++td) {
                f32x4 acc = (f32x4){0.f, 0.f, 0.f, 0.f};
                acc = mma_lds(vT + w * 16 * LDT, ke + td * 16 * LDT, LDT, LDT, 64, acc, fr, fq);
#pragma unroll
                for (int jj = 0; jj < 4; ++jj) dst[(w * 16 + fq * 4 + jj) * 64 + td * 16 + fr] = f2bf(acc[jj]);
            }
        }
        __syncthreads();
    }
}

__device__ __forceinline__ void g2_phase(const Params& p) {
    const bf16_t* UT = (const bf16_t*)(p.ws + WS_UT); bf16_t* ST = (bf16_t*)(p.ws + WS_ST); const float* DEC = (const float*)(p.ws + WS_DEC);
    for (int item = blockIdx.x * NTHREADS + opaque_tid(); item < 128 * 1024; item += gridDim.x * NTHREADS) {
        const int seq = item >> 10, e8 = item & 1023, e = e8 >> 3, d0 = (e8 & 7) * 8;
        const size_t slot0 = (size_t)seq * NCHS;
        float S[8];
#pragma unroll
        for (int i = 0; i < 8; ++i) S[i] = 0.f;
#pragma unroll 4
        for (int pp = 0; pp < NCHS; ++pp) {
            const u32x4 uu = *(const u32x4*)(UT + (slot0 + pp) * 8192 + e * 64 + d0);
            const f32x4 dc0 = *(const f32x4*)(DEC + (slot0 + pp) * 64 + d0), dc1 = *(const f32x4*)(DEC + (slot0 + pp) * 64 + d0 + 4);
            u32x4 o; o.x = cvt_pk_bf16(S[0], S[1]); o.y = cvt_pk_bf16(S[2], S[3]); o.z = cvt_pk_bf16(S[4], S[5]); o.w = cvt_pk_bf16(S[6], S[7]);
            *(u32x4*)(ST + (slot0 + pp) * 8192 + e * 64 + d0) = o;
            S[0] = dc0[0] * S[0] + bflo(uu.x); S[1] = dc0[1] * S[1] + bfhi(uu.x); S[2] = dc0[2] * S[2] + bflo(uu.y); S[3] = dc0[3] * S[3] + bfhi(uu.y);
            S[4] = dc1[0] * S[4] + bflo(uu.z); S[5] = dc1[1] * S[5] + bfhi(uu.z); S[6] = dc1[2] * S[6] + bflo(uu.w); S[7] = dc1[3] * S[7] + bfhi(uu.w);
        }
    }
}

template <int W>
__device__ __forceinline__ void pool_win(const float (&x)[31], int tlb, int seqlen, LAS bf16_t* dst) {
    float s = 0.f;
#pragma unroll
    for (int k = 8 - W / 2; k <= 8 + (W - 1 - W / 2); ++k) s += x[k];
#pragma unroll
    for (int tt = 0; tt < 16; ++tt) {
        const int tl = tlb + tt; int lo = tl - W / 2; if (lo < 0) lo = 0; int hi = tl + (W - 1 - W / 2); if (hi > seqlen - 1) hi = seqlen - 1;
        dst[tt * LDP] = f2bf(s / (float)(hi - lo + 1) - x[tt + 8]);
        if (tt < 15) s += x[tt + 8 + (W - 1 - W / 2) + 1] - x[tt + 8 - W / 2];
    }
}

__device__ __forceinline__ void g3_phase(const Params& p, int l, bool last, LAS unsigned char* lds) {
    const int tid = opaque_tid(), lane = tid & 63, w = tid >> 6, fr = lane & 15, fq = lane >> 4;
    const bf16_t* P = (const bf16_t*)(p.ws + WS_PROJ); const bf16_t* ST = (const bf16_t*)(p.ws + WS_ST);
    bf16_t* A = (bf16_t*)(p.ws + WS_A);
    LAS float* bF = (LAS float*)(lds + L_BF); LAS float* bB = (LAS float*)(lds + L_BB); LAS float* part = (LAS float*)(lds + L_PART);
    LAS bf16_t* qF = (LAS bf16_t*)(lds + L_QF); LAS bf16_t* kF = (LAS bf16_t*)(lds + L_KF); LAS bf16_t* qB = (LAS bf16_t*)(lds + L_QB); LAS bf16_t* kB = (LAS bf16_t*)(lds + L_KB);
    LAS bf16_t* pF = (LAS bf16_t*)(lds + L_PF); LAS bf16_t* pB = (LAS bf16_t*)(lds + L_PB); LAS bf16_t* vT = (LAS bf16_t*)(lds + L_VT);
    LAS bf16_t* sF = (LAS bf16_t*)(lds + L_SF); LAS bf16_t* sB = (LAS bf16_t*)(lds + L_SB);
    const int nunits = last ? 4096 : 4352;
    for (int u = blockIdx.x; u < nunits; u += gridDim.x) {
        const GUnit g = decode_unit(u);
        const int t = tid >> 3, d0 = (tid & 7) * 8;
        const u32x4 q8 = *(const u32x4*)(P + (size_t)(g.row0 + t) * NPROJ + 512 + g.h * 64 + d0);
        const u32x4 k8 = *(const u32x4*)(P + (size_t)(g.row0 + t) * NPROJ + 768 + g.h * 64 + d0);
        stage_vT(p, g, lds);
#pragma unroll
        for (int i = 0; i < 2; ++i) { const int c = tid + 512 * i, e = c >> 3, dc = (c & 7) * 8;
            *(LAS u32x4*)(sF + e * LDT + dc) = *(const u32x4*)(ST + (size_t)g.slot_f * 8192 + e * 64 + dc);
            *(LAS u32x4*)(sB + e * LDT + dc) = *(const u32x4*)(ST + (size_t)g.slot_b * 8192 + e * 64 + dc); }
        compute_decay(p, l, g, lds);
        { const float qf[8] = {bflo(q8.x), bfhi(q8.x), bflo(q8.y), bfhi(q8.y), bflo(q8.z), bfhi(q8.z), bflo(q8.w), bfhi(q8.w)};
          const float kf[8] = {bflo(k8.x), bfhi(k8.x), bflo(k8.y), bfhi(k8.y), bflo(k8.z), bfhi(k8.z), bflo(k8.w), bfhi(k8.w)};
          float a[8], b[8], c[8], dd2[8];
#pragma unroll
          for (int dd = 0; dd < 8; ++dd) { const float bf = bF[t * 64 + d0 + dd], bb = bB[t * 64 + d0 + dd];
              a[dd] = qf[dd] * 0.125f * __expf(bf); b[dd] = kf[dd] * __expf(-bf); c[dd] = qf[dd] * 0.125f * __expf(bb); dd2[dd] = kf[dd] * __expf(-bb); }
          u32x4 o;
          o.x = cvt_pk_bf16(a[0], a[1]); o.y = cvt_pk_bf16(a[2], a[3]); o.z = cvt_pk_bf16(a[4], a[5]); o.w = cvt_pk_bf16(a[6], a[7]); *(LAS u32x4*)(qF + t * LDT + d0) = o;
          o.x = cvt_pk_bf16(b[0], b[1]); o.y = cvt_pk_bf16(b[2], b[3]); o.z = cvt_pk_bf16(b[4], b[5]); o.w = cvt_pk_bf16(b[6], b[7]); *(LAS u32x4*)(kF + t * LDT + d0) = o;
          o.x = cvt_pk_bf16(c[0], c[1]); o.y = cvt_pk_bf16(c[2], c[3]); o.z = cvt_pk_bf16(c[4], c[5]); o.w = cvt_pk_bf16(c[6], c[7]); *(LAS u32x4*)(qB + t * LDT + d0) = o;
          o.x = cvt_pk_bf16(dd2[0], dd2[1]); o.y = cvt_pk_bf16(dd2[2], dd2[3]); o.z = cvt_pk_bf16(dd2[4], dd2[5]); o.w = cvt_pk_bf16(dd2[6], dd2[7]); *(LAS u32x4*)(kB + t * LDT + d0) = o; }
        __syncthreads();
        {
          const int dir = w >> 2, ti = w & 3;
          const LAS bf16_t* qq = dir ? qB : qF; const LAS bf16_t* kk = dir ? kB : kF; LAS bf16_t* pp = dir ? pB : pF;
#pragma unroll
          for (int tj = 0; tj < 4; ++tj) {
              f32x4 acc = (f32x4){0.f, 0.f, 0.f, 0.f};
              const bool live = dir ? (tj >= ti) : (tj <= ti);
              if (live) acc = mma_lds(qq + ti * 16 * LDT, kk + tj * 16 * LDT, LDT, LDT, 64, acc, fr, fq);
#pragma unroll
              for (int jj = 0; jj < 4; ++jj) { const int i = ti * 16 + fq * 4 + jj, j = tj * 16 + fr; const bool keep = dir ? (j >= i) : (j <= i);
                  pp[i * LDT + j] = f2bf(keep ? acc[jj] : 0.f); }
          } }
        unsigned short rr16[4][4];
#pragma unroll
        for (int ti = 0; ti < 4; ++ti)
#pragma unroll
            for (int jj = 0; jj < 4; ++jj) rr16[ti][jj] = P[(size_t)(g.row0 + ti * 16 + fq * 4 + jj) * NPROJ + 1536 + g.h * 128 + w * 16 + fr];
        __syncthreads();
        f32x4 oacc[4];
#pragma unroll
        for (int ti = 0; ti < 4; ++ti) oacc[ti] = (f32x4){0.f, 0.f, 0.f, 0.f};
#pragma unroll
        for (int dir = 0; dir < 2; ++dir) {
            const LAS bf16_t* qq = dir ? qB : qF; const LAS bf16_t* pp = dir ? pB : pF; const LAS bf16_t* ss = dir ? sB : sF;
#pragma unroll
            for (int ti = 0; ti < 4; ++ti) {
                oacc[ti] = mma_lds(pp + ti * 16 * LDT, vT + w * 16 * LDT, LDT, LDT, 64, oacc[ti], fr, fq);
                oacc[ti] = mma_lds(qq + ti * 16 * LDT, ss + w * 16 * LDT, LDT, LDT, 64, oacc[ti], fr, fq);
            }
        }
        const int tl0 = g.row0 - g.seq0;
        u32x4 uwv[3], pwv[4];
#pragma unroll
        for (int i = 0; i < 3; ++i) { const int c = tid + 512 * i, rw = c >> 4, cc = (c & 15) * 8, pos = tl0 - 8 + rw;
            uwv[i] = (u32x4){0u, 0u, 0u, 0u};
            if (c < 80 * 16 && pos >= 0 && pos < g.seqlen) uwv[i] = *(const u32x4*)(P + (size_t)(g.seq0 + pos) * NPROJ + g.h * 128 + cc); }
        { const bf16_t* pwsrc = (const bf16_t*)(p.ws + WS_PW) + (size_t)(l * 4 + g.h) * 128 * 128;
#pragma unroll
          for (int i = 0; i < 4; ++i) { const int c = tid + 512 * i, dr = c >> 4, cc = (c & 15) * 8; pwv[i] = *(const u32x4*)(pwsrc + dr * 128 + cc); } }
#pragma unroll
        for (int ti = 0; ti < 4; ++ti)
#pragma unroll
            for (int jj = 0; jj < 4; ++jj) { float ss = oacc[ti][jj] * oacc[ti][jj];
                ss += __shfl_xor(ss, 1); ss += __shfl_xor(ss, 2); ss += __shfl_xor(ss, 4); ss += __shfl_xor(ss, 8);
                if (fr == 0) part[(ti * 16 + fq * 4 + jj) * 8 + w] = ss; }
        __syncthreads();
        { const int e = w * 16 + fr; const float gn = p.gla_norm_g[l * 512 + g.h * 128 + e];
#pragma unroll
          for (int ti = 0; ti < 4; ++ti)
#pragma unroll
              for (int jj = 0; jj < 4; ++jj) { const int i = ti * 16 + fq * 4 + jj;
                  const f32x4 p0 = *(const LAS f32x4*)(part + i * 8), p1 = *(const LAS f32x4*)(part + i * 8 + 4);
                  const float tot = ((p0[0] + p0[1]) + (p0[2] + p0[3])) + ((p1[0] + p1[1]) + (p1[2] + p1[3]));
                  const float rstd = 1.0f / sqrtf(tot * (1.0f / 128.0f) + LN_EPS);
                  const float rr = bf2f(rr16[ti][jj]);
                  A[(size_t)(g.row0 + i) * D + 512 + g.h * 128 + e] = f2bf(oacc[ti][jj] * rstd * gn * silu_f(rr)); } }
        __syncthreads();
        { LAS float* uw = (LAS float*)(lds + L_UW); LAS bf16_t* pooled = (LAS bf16_t*)(lds + L_POOLED); LAS bf16_t* pwT = (LAS bf16_t*)(lds + L_PWT);
#pragma unroll
          for (int i = 0; i < 3; ++i) { const int c = tid + 512 * i, rw = c >> 4, cc = (c & 15) * 8;
              if (c < 80 * 16) { const u32x4 v8 = uwv[i];
                  *(LAS f32x4*)(uw + rw * 128 + cc) = (f32x4){bflo(v8.x), bfhi(v8.x), bflo(v8.y), bfhi(v8.y)};
                  *(LAS f32x4*)(uw + rw * 128 + cc + 4) = (f32x4){bflo(v8.z), bfhi(v8.z), bflo(v8.w), bfhi(v8.w)}; } }
#pragma unroll
          for (int i = 0; i < 4; ++i) { const int c = tid + 512 * i, dr = c >> 4, cc = (c & 15) * 8; *(LAS u32x4*)(pwT + dr * LDP + cc) = pwv[i]; }
          __syncthreads();
          { const int c = tid & 127, tq = tid >> 7;
            float x[31];
#pragma unroll
            for (int k = 0; k < 31; ++k) x[k] = uw[(16 * tq + k) * 128 + c];
            LAS bf16_t* dst = pooled + (16 * tq) * LDP + c;
            if (g.h == 0) pool_win<2>(x, tl0 + 16 * tq, g.seqlen, dst);
            else if (g.h == 1) pool_win<4>(x, tl0 + 16 * tq, g.seqlen, dst);
            else if (g.h == 2) pool_win<8>(x, tl0 + 16 * tq, g.seqlen, dst);
            else pool_win<16>(x, tl0 + 16 * tq, g.seqlen, dst); }
          __syncthreads();
          { const int dcol = w * 16 + fr; const float ps = p.pool_scale[l * 512 + g.h * 128 + dcol];
#pragma unroll
            for (int ti = 0; ti < 4; ++ti) { f32x4 acc = (f32x4){0.f, 0.f, 0.f, 0.f};
                acc = mma_lds(pooled + ti * 16 * LDP, pwT + w * 16 * LDP, LDP, LDP, 128, acc, fr, fq);
#pragma unroll
                for (int jj = 0; jj < 4; ++jj) A[(size_t)(g.row0 + ti * 16 + fq * 4 + jj) * D + g.h * 128 + dcol] = f2bf(acc[jj] * ps); } }
          __syncthreads(); }
    }
}

#define XB_TMO      128
#define XB_XCNT(j)  (256  + 64 * (j))
#define XB_XSUB(j)  (1280 + 64 * (j))
#define XB_XGEN(j)  (2304 + 64 * (j))
#define XB_TOP      3328
#define XB_TOPGEN   3392
#define XCD_BAR_WORDS 3456
#define XB_SPIN_CAP (1u << 20)
__device__ __forceinline__ unsigned xb_ld(unsigned* p)              { return __hip_atomic_load(p, __ATOMIC_RELAXED, __HIP_MEMORY_SCOPE_AGENT); }
__device__ __forceinline__ unsigned xb_add(unsigned* p, unsigned v) { return __hip_atomic_fetch_add(p, v, __ATOMIC_RELAXED, __HIP_MEMORY_SCOPE_AGENT); }
__device__ __forceinline__ unsigned xb_xcc_id() { return (unsigned)__builtin_amdgcn_s_getreg((3 << 11) | 20) & 0xFu; }
#define XB_SPIN(cond, bar) do { unsigned _sp = 0; while (cond) { __builtin_amdgcn_s_sleep(1); \
    if ((++_sp & 255u) == 0u) { if (xb_ld(&(bar)[XB_TMO])) break; if (_sp > XB_SPIN_CAP) { atomicAdd(&(bar)[XB_TMO], 1u); break; } } } } while (0)
struct XcdBarrier { unsigned* bar; unsigned x; volatile LAS unsigned* st; };
__device__ __forceinline__ XcdBarrier xcd_barrier_post(unsigned* bar, volatile LAS unsigned* st) {
    XcdBarrier b; b.bar = bar; b.x = xb_xcc_id(); b.st = st;
    if (threadIdx.x == 0) (void)xb_add(&bar[XB_XCNT(b.x)], 1u);
    return b;
}
__device__ __forceinline__ void xcd_barrier_complete(unsigned* bar, unsigned x, unsigned& nloc, unsigned& nx) {
    const unsigned G = gridDim.x * gridDim.y * gridDim.z;
    unsigned sum, cnt, mine, sp = 0u;
    for (;;) {
        sum = 0u; cnt = 0u; mine = 0u;
#pragma unroll
        for (unsigned j = 0; j < 16; ++j) { const unsigned c = xb_ld(&bar[XB_XCNT(j)]); sum += c; cnt += (c > 0u) ? 1u : 0u; mine = (j == x) ? c : mine; }
        if (sum == G) break;
        __builtin_amdgcn_s_sleep(1);
        if ((++sp & 255u) == 0u) { if (xb_ld(&bar[XB_TMO])) break; if (sp > XB_SPIN_CAP) { atomicAdd(&bar[XB_TMO], 1u); break; } }
    }
    nloc = mine > 0u ? mine : 1u; nx = cnt > 0u ? cnt : 1u;
}
__device__ __forceinline__ void xcd_barrier(const XcdBarrier& b) {
    asm volatile("s_waitcnt vmcnt(0)" ::: "memory");
    __syncthreads();
    if (threadIdx.x == 0) {
        unsigned* bar = b.bar;
        __builtin_amdgcn_s_waitcnt(0);
        unsigned nloc = b.st[0], nx = b.st[1];
        if (nloc == 0u) { xcd_barrier_complete(bar, b.x, nloc, nx); b.st[0] = nloc; b.st[1] = nx; }
        const unsigned old = xb_add(&bar[XB_XSUB(b.x)], 1u);
        const unsigned gen = old / nloc;
        if (old + 1u == (gen + 1u) * nloc) {
            __builtin_amdgcn_fence(__ATOMIC_RELEASE, "agent");
            asm volatile("s_waitcnt vmcnt(0)" ::: "memory");
            const unsigned og = xb_add(&bar[XB_TOP], 1u);
            const unsigned tg = og / nx;
            if (og + 1u == (tg + 1u) * nx) xb_add(&bar[XB_TOPGEN], 1u);
            else XB_SPIN(xb_ld(&bar[XB_TOPGEN]) == tg, bar);
            __builtin_amdgcn_fence(__ATOMIC_ACQUIRE, "agent");
            xb_add(&bar[XB_XGEN(b.x)], 1u);
            asm volatile("s_waitcnt vmcnt(0)" ::: "memory");
        } else {
            XB_SPIN(xb_ld(&bar[XB_XGEN(b.x)]) == gen, bar);
            __builtin_amdgcn_fence(__ATOMIC_ACQUIRE, "agent");
            asm volatile("s_waitcnt vmcnt(0)" ::: "memory");
        }
    }
    __syncthreads();
}

constexpr int NPHASE = 2 + 12 * DEPTH;
#ifndef NPH_RUN
#define NPH_RUN NPHASE
#endif
__global__ void __launch_bounds__(NTHREADS, 2) fwd_kernel(Params p) {
    extern __shared__ __attribute__((aligned(16))) unsigned char lds_raw[];
    LAS unsigned char* lds = (LAS unsigned char*)lds_raw;
    unsigned char* ws = p.ws;
    float* HC = (float*)(ws + WS_HC); bf16_t* A = (bf16_t*)(ws + WS_A); bf16_t* HID = (bf16_t*)(ws + WS_HID);
    const float* mod = (const float*)(ws + WS_MOD);
    volatile LAS unsigned* misc = (volatile LAS unsigned*)(lds + LDS_MISC);
    if (threadIdx.x < 4) misc[threadIdx.x] = 0u;
    __syncthreads();
    XcdBarrier xbar; xbar.bar = (unsigned*)(ws + WS_CTL); xbar.x = 0; xbar.st = misc;
    if (p.ph_hi - p.ph_lo > 1) xbar = xcd_barrier_post((unsigned*)(ws + WS_CTL), misc);
    if (p.ph_lo >= 100) {
        const int sel = p.ph_lo - 100; const size_t NO = (size_t)MLAT * D;
        const bf16_t* PJ = (const bf16_t*)(ws + WS_PROJ); const float* GDp = (const float*)(ws + WS_GD); const bf16_t* UT = (const bf16_t*)(ws + WS_UT); const bf16_t* ST = (const bf16_t*)(ws + WS_ST); const float* DEC = (const float*)(ws + WS_DEC);
        for (size_t i = (size_t)blockIdx.x * NTHREADS + threadIdx.x; i < NO; i += (size_t)gridDim.x * NTHREADS) {
            float v = 0.f;
            if (sel == 0) v = bf2f(PJ[i]) + bf2f(PJ[i + NO]);
            else if (sel == 1) v = GDp[i % ((size_t)MTOT * 32)];
            else if (sel == 2) v = bf2f(UT[i]) + (i < 4000000 ? bf2f(UT[i + NO]) : 0.f) + DEC[i % (SLOTS * 64)];
            else if (sel == 3) v = bf2f(ST[i]) + (i < 4000000 ? bf2f(ST[i + NO]) : 0.f);
            else if (sel == 5) v = DEC[i % (SLOTS * 64)];
            else if (sel == 6) v = bf2f(UT[i]) + (i < 4000000 ? bf2f(UT[i + NO]) : 0.f);
            else v = bf2f(A[i]) + (i < 4000000 ? bf2f(A[i + NO]) : 0.f);
            p.out[i] = v;
        }
        return;
    }
#ifndef REP_MASK
#define REP_MASK 0
#endif
    for (int ph = p.ph_lo; ph < p.ph_hi; ++ph) {
      const int nrep = (REP_MASK != 0 && ph >= 2 && ((REP_MASK >> ((ph - 2) % 12)) & 1)) ? 2 : 1;
      for (int rep = 0; rep < nrep; ++rep) {
        if (rep) xcd_barrier(xbar);
        if (ph == 0) phase0a(p, lds);
        else if (ph == 1) ln_phase(p.x, p.ctx, p.out, HC, A, nullptr, nullptr, (const float*)(ws + WS_TAB), mod, 0, 1);
        else {
            const int l = (ph - 2) / 12, s = (ph - 2) % 12; const bool last = (l == DEPTH - 1);
            const float* modl = mod + (size_t)l * 17 * NMOD * D;
            float* o_lat = rep ? (float*)(ws + WS_UT) : p.out; float* o_ctx = rep ? (float*)(ws + WS_UT) + (size_t)MLAT * D - (size_t)MCTX * D : HC;
            bf16_t* o_A = rep ? HID : A;
            if (s == 0 || s == 9) {
                pg8::Gemm g{A, (const bf16_t*)(ws + (s == 0 ? WS_WFA1 : WS_WFB1)) + (size_t)l * 2 * DFF * D, MTOT, 2 * DFF, D};
                pg8::StaticOrder S; S.init(MTOT, 2 * DFF, gridDim.x, blockIdx.x);
                EpiSwiglu E{HID}; pg8::gemm_phase<EpiSwiglu>(lds, g, S, E);
            } else if (s == 1 || s == 10) {
                pg8::Gemm g{HID, (const bf16_t*)(ws + (s == 1 ? WS_WFA2 : WS_WFB2)) + (size_t)l * D * DFF, MTOT, D, DFF};
                pg8::StaticOrder S; S.init(MTOT, D, gridDim.x, blockIdx.x);
                EpiResid E{o_lat, o_ctx, modl + (s == 1 ? 2 : 8) * D, 0.5f}; pg8::gemm_phase<EpiResid>(lds, g, S, E);
            } else if (s == 7) {
                pg8::Gemm g{A, (const bf16_t*)(ws + WS_WMO) + (size_t)l * D * D, MTOT, D, D};
                pg8::StaticOrder S; S.init(MTOT, D, gridDim.x, blockIdx.x);
                EpiResid E{o_lat, o_ctx, modl + 5 * D, 1.0f}; pg8::gemm_phase<EpiResid>(lds, g, S, E);
            } else if (s == 3) {
                pg8::Gemm g{A, (const bf16_t*)(ws + WS_WMI) + (size_t)l * NIN * D, MTOT, NIN, D};
                pg8::StaticOrder S; S.init(MTOT, NIN, gridDim.x, blockIdx.x);
                EpiMixIn E{(bf16_t*)(ws + WS_PROJ), (float*)(ws + WS_GD)}; pg8::gemm_phase<EpiMixIn>(lds, g, S, E);
            } else if (s == 2) ln_phase(o_lat, o_ctx, o_lat, o_ctx, o_A, p.ln_g + (l * 3 + 0) * D, p.ln_b + (l * 3 + 0) * D, nullptr, modl, 3, 4);
            else if (s == 8) ln_phase(o_lat, o_ctx, o_lat, o_ctx, o_A, p.ln_g + (l * 3 + 1) * D, p.ln_b + (l * 3 + 1) * D, nullptr, modl, 6, 7);
            else if (s == 11) ln_phase(o_lat, o_ctx, o_lat, o_ctx, o_A, p.ln_g + (l * 3 + 2) * D, p.ln_b + (l * 3 + 2) * D, nullptr, last ? nullptr : modl + (size_t)17 * NMOD * D, 0, 1);
            else if (s == 4) g1_phase(p, l, lds);
            else if (s == 5) g2_phase(p);
            else g3_phase(p, l, last, lds);
        }
      }
        if (ph + 1 < p.ph_hi) { if (ph == p.ph_lo) cg::this_grid().sync(); else xcd_barrier(xbar); }
    }
}

extern "C" void kernel_launch(void* const* d_in, const int* in_sizes, int n_in, void* d_out, int out_size, void* d_ws, size_t ws_size, hipStream_t stream) {
    static int grid = 0;
    if (grid == 0) {
        int dev = 0, cus = 0, per_cu = 0;
        hipGetDevice(&dev);
        hipDeviceGetAttribute(&cus, hipDeviceAttributeMultiprocessorCount, dev);
        if (hipFuncSetAttribute((const void*)fwd_kernel, hipFuncAttributeMaxDynamicSharedMemorySize, LDS_BYTES) != hipSuccess) fprintf(stderr, "kernel_launch: hipFuncSetAttribute failed\n");
        if (hipOccupancyMaxActiveBlocksPerMultiprocessor(&per_cu, (const void*)fwd_kernel, NTHREADS, LDS_BYTES) != hipSuccess || per_cu < 1) { fprintf(stderr, "kernel_launch: occupancy query says %d\n", per_cu); per_cu = 1; }
        (void)hipGetLastError();
        grid = cus * per_cu;
        if (ws_size < WS_END) fprintf(stderr, "kernel_launch: workspace too small (%zu < %zu)\n", ws_size, (size_t)WS_END);
    }
    Params p{};
    const float** fp = (const float**)&p;
    for (int i = 0; i < 21; ++i) fp[i] = (const float*)d_in[i];
    p.out = (float*)d_out; p.ws = (unsigned char*)d_ws;
#if ONE_LAUNCH
    (void)hipMemsetAsync((char*)d_ws + WS_CTL, 0, 16384, stream);
    p.ph_lo = 0; p.ph_hi = NPHASE;
    void* args[] = {&p};
    hipError_t e = hipLaunchCooperativeKernel((const void*)fwd_kernel, dim3(grid), dim3(NTHREADS), args, LDS_BYTES, stream);
    if (e != hipSuccess) fprintf(stderr, "cooperative launch failed: %s (grid %d)\n", hipGetErrorString(e), grid);
#else
    for (int ph = 0; ph < NPH_RUN; ++ph) {
        p.ph_lo = ph; p.ph_hi = ph + 1;
        hipLaunchKernelGGL(fwd_kernel, dim3(grid), dim3(NTHREADS), LDS_BYTES, stream, p);
    }
#ifdef DUMP_SEL
    p.ph_lo = 100 + DUMP_SEL; p.ph_hi = 0;
    hipLaunchKernelGGL(fwd_kernel, dim3(grid), dim3(NTHREADS), LDS_BYTES, stream, p);
#endif
#endif
}
```
